# Optimizing an MI355X kernel written in HIP

```python
import math
import jax, jax.numpy as jnp
from jax import lax
import numpy as np

D_MODEL = 1024
BATCH = 4
SEQ = 4096
DEPTH = 4

GRID_W = 64
CTX_LEN = 256

N_MIXERS = 4
MIX_CONV, MIX_NAT, MIX_MLA, MIX_FNET = 0, 1, 2, 3
N_MOD = 6

FFN_HIDDEN = -(-8 * D_MODEL // (3 * 256)) * 256

NA_HEADS = 16
NA_HEAD_DIM = D_MODEL // NA_HEADS
NA_WIN_ROWS = 8
NA_WIN_COLS = 16

MLA_HEADS = 16
MLA_Q_RANK = D_MODEL // 4
MLA_KV_RANK = D_MODEL // 4
MLA_NOPE = 64
MLA_ROPE = 32
MLA_V = 64

FNET_GROUPS = 4

ROPE_BASE = 10000.0
NORM_EPS = 1e-6
Q_BLOCK = 128

kernel_name = "hybrid_interleaved_diffusion_trunk"


def rmsnorm(x, g):
    x32 = x.astype(jnp.float32)
    y = x32 * lax.rsqrt(jnp.mean(x32 * x32, axis=-1, keepdims=True) + NORM_EPS)
    return y.astype(x.dtype) * g


def modulate(h, shift, scale):
    return h * (1 + scale) + shift


def axial_rope_tables(n_tokens, rot_dim):
    n_freq = rot_dim // 4
    freq = ROPE_BASE ** (-jnp.arange(n_freq, dtype=jnp.float32) / n_freq)
    t = jnp.arange(n_tokens)
    row = (t // GRID_W).astype(jnp.float32)
    col = (t % GRID_W).astype(jnp.float32)
    ang = jnp.concatenate([row[:, None] * freq, col[:, None] * freq], axis=-1)
    return jnp.cos(ang), jnp.sin(ang)


def apply_rope(x, cos, sin):
    half = x.shape[-1] // 2
    x1, x2 = x[..., :half], x[..., half:]
    return jnp.concatenate([x1 * cos - x2 * sin, x1 * sin + x2 * cos], axis=-1).astype(x.dtype)


def blocked_attention(q, k, v, scale):
    B, Sq, H, dq = q.shape
    nb = Sq // Q_BLOCK
    qb = q.reshape(B, nb, Q_BLOCK, H, dq).transpose(1, 0, 2, 3, 4)

    def one_block(q_blk):
        s = jnp.einsum('bqhd,bkhd->bhqk', q_blk, k).astype(jnp.float32) * scale
        p = jax.nn.softmax(s, axis=-1).astype(v.dtype)
        return jnp.einsum('bhqk,bkhd->bqhd', p, v)

    o = lax.map(one_block, qb)
    return o.transpose(1, 0, 2, 3, 4).reshape(B, Sq, H, v.shape[-1])


def swiglu(h, w_in, w_out):
    gate, up = jnp.split(h @ w_in, 2, axis=-1)
    return (jax.nn.silu(gate) * up) @ w_out


def short_conv_mixer(h, w_in, conv_w, w_out):
    b_gate, c_gate, v = jnp.split(h @ w_in, 3, axis=-1)
    u = c_gate * v
    up = jnp.pad(u, ((0, 0), (1, 1), (0, 0)))
    z = conv_w[0] * up[:, :-2] + conv_w[1] * up[:, 1:-1] + conv_w[2] * up[:, 2:]
    return (b_gate * z) @ w_out


def neighbourhood_attention(hl, hc, w_qkv, rpb, w_o, want_ctx):
    B, S, D = hl.shape
    H, dh = NA_HEADS, NA_HEAD_DIM
    rows = S // GRID_W
    kr = min(NA_WIN_ROWS, rows)
    kc = NA_WIN_COLS
    scale = dh ** -0.5

    qkv = hl @ w_qkv
    to_grid = lambda t: t.reshape(B, rows, GRID_W, H, dh).transpose(0, 3, 1, 2, 4)
    qg, kg, vg = to_grid(qkv[..., :D]), to_grid(qkv[..., D:2 * D]), to_grid(qkv[..., 2 * D:])

    kv_c = hc @ w_qkv[:, D:]
    k_ctx = kv_c[..., :D].reshape(B, -1, H, dh)
    v_ctx = kv_c[..., D:].reshape(B, -1, H, dh)

    cols = jnp.arange(GRID_W)
    c0 = jnp.clip(cols - kc // 2, 0, GRID_W - kc)
    col_idx = c0[:, None] + jnp.arange(kc)
    col_bias = rpb[:, :, col_idx - cols[:, None] + NA_WIN_COLS - 1]

    def row_block(r):
        r0 = jnp.clip(r - kr // 2, 0, rows - kr)
        q_r = lax.dynamic_index_in_dim(qg, r, axis=2, keepdims=False)
        k_band = lax.dynamic_slice_in_dim(kg, r0, kr, axis=2)
        v_band = lax.dynamic_slice_in_dim(vg, r0, kr, axis=2)
        k_win = k_band[:, :, :, col_idx]
        v_win = v_band[:, :, :, col_idx]
        row_off = r0 + jnp.arange(kr) - r + NA_WIN_ROWS - 1
        bias = jnp.take(col_bias, row_off, axis=1).transpose(0, 2, 1, 3)
        s_win = (jnp.einsum('bhqd,bhrqcd->bhqrc', q_r, k_win).astype(jnp.float32) * scale
                 + bias[None].astype(jnp.float32))
        s_ctx = jnp.einsum('bhqd,bkhd->bhqk', q_r, k_ctx).astype(jnp.float32) * scale
        s = jnp.concatenate([s_win.reshape(B, H, GRID_W, kr * kc), s_ctx], axis=-1)
        p = jax.nn.softmax(s, axis=-1).astype(v_win.dtype)
        p_win = p[..., :kr * kc].reshape(B, H, GRID_W, kr, kc)
        p_ctx = p[..., kr * kc:]
        return (jnp.einsum('bhqrc,bhrqcd->bhqd', p_win, v_win)
                + jnp.einsum('bhqk,bkhd->bhqd', p_ctx, v_ctx))

    o = lax.map(row_block, jnp.arange(rows))
    yl = o.transpose(1, 0, 3, 2, 4).reshape(B, S, D) @ w_o

    yc = None
    if want_ctx:
        q_ctx = (hc @ w_qkv[:, :D]).reshape(B, -1, H, dh)
        yc = blocked_attention(q_ctx, k_ctx, v_ctx, scale).reshape(B, -1, D) @ w_o
    return yl, yc


def mla_queries(h, w_dq, q_g, w_uq):
    B, S, _ = h.shape
    q = (rmsnorm(h @ w_dq, q_g) @ w_uq).reshape(B, S, MLA_HEADS, MLA_NOPE + MLA_ROPE)
    return q[..., :MLA_NOPE], q[..., MLA_NOPE:]


def mla_keys_values(h, w_dkv, kv_g, w_ukv):
    B, S, _ = h.shape
    ckv = h @ w_dkv
    c_kv = rmsnorm(ckv[..., :MLA_KV_RANK], kv_g)
    k_rope = ckv[..., MLA_KV_RANK:]
    kv = (c_kv @ w_ukv).reshape(B, S, MLA_HEADS, MLA_NOPE + MLA_V)
    return kv[..., :MLA_NOPE], k_rope, kv[..., MLA_NOPE:]


def mla_join(nope, rope):
    if rope.ndim == 3:
        rope = jnp.broadcast_to(rope[:, :, None, :], nope.shape[:3] + (rope.shape[-1],))
    return jnp.concatenate([nope, rope], axis=-1)


def latent_attention(hl, hc, w_dq, q_g, w_uq, w_dkv, kv_g, w_ukv, w_o, cos, sin, want_ctx):
    B, S, _ = hl.shape
    scale = (MLA_NOPE + MLA_ROPE) ** -0.5
    qn, qr = mla_queries(hl, w_dq, q_g, w_uq)
    kn, kr, v = mla_keys_values(hl, w_dkv, kv_g, w_ukv)
    q_l = mla_join(qn, apply_rope(qr, cos[:, None, :], sin[:, None, :]))
    k_l = mla_join(kn, apply_rope(kr, cos, sin))
    kn_c, kr_c, v_c = mla_keys_values(hc, w_dkv, kv_g, w_ukv)
    k_c = mla_join(kn_c, kr_c)
    k_all = jnp.concatenate([k_l, k_c], axis=1)
    v_all = jnp.concatenate([v, v_c], axis=1)
    yl = blocked_attention(q_l, k_all, v_all, scale).reshape(B, S, MLA_HEADS * MLA_V) @ w_o
    yc = None
    if want_ctx:
        qn_c, qr_c = mla_queries(hc, w_dq, q_g, w_uq)
        o_c = blocked_attention(mla_join(qn_c, qr_c), k_c, v_c, scale)
        yc = o_c.reshape(B, -1, MLA_HEADS * MLA_V) @ w_o
    return yl, yc


def fourier_mixer(h, w_o):
    B, S, D = h.shape
    hg = h.astype(jnp.float32).reshape(B, S, FNET_GROUPS, D // FNET_GROUPS)
    f = jnp.fft.fftn(hg, axes=(1, 3), norm="ortho").real
    return f.reshape(B, S, D).astype(h.dtype) @ w_o


def setup_inputs(seed: int = 0) -> dict:
    key = jax.random.key(seed)
    ks = iter(jax.random.split(key, 32))
    D, F = D_MODEL, FFN_HIDDEN
    n_conv = len(range(MIX_CONV, DEPTH, N_MIXERS))
    n_nat = len(range(MIX_NAT, DEPTH, N_MIXERS))
    n_mla = len(range(MIX_MLA, DEPTH, N_MIXERS))
    n_fnet = len(range(MIX_FNET, DEPTH, N_MIXERS))

    def nrm(shape, scale):
        return jax.random.normal(next(ks), shape, jnp.float32) * scale

    def gain(shape):
        return 1.0 + nrm(shape, 0.05)

    return {
        "x": nrm((BATCH, SEQ, D), 1.0),
        "c": nrm((BATCH, D), 1.0),
        "ctx": nrm((BATCH, CTX_LEN, D), 1.0),
        "c_ctx": nrm((D,), 1.0),
        "mod_w": nrm((DEPTH, D, N_MOD * D), 0.5 * D ** -0.5),
        "mod_b": nrm((DEPTH, N_MOD * D), 0.02),
        "mix_norm_g": gain((DEPTH, D)),
        "ffn_norm_g": gain((DEPTH, D)),
        "conv_w_in": nrm((n_conv, D, 3 * D), D ** -0.5),
        "conv_w": nrm((n_conv, 3, D), 3 ** -0.5),
        "conv_w_out": nrm((n_conv, D, D), D ** -0.5),
        "nat_w_qkv": nrm((n_nat, D, 3 * D), D ** -0.5),
        "nat_rpb": nrm((n_nat, NA_HEADS, 2 * NA_WIN_ROWS - 1, 2 * NA_WIN_COLS - 1), 0.1),
        "nat_w_o": nrm((n_nat, D, D), D ** -0.5),
        "mla_w_dq": nrm((n_mla, D, MLA_Q_RANK), D ** -0.5),
        "mla_q_norm_g": gain((n_mla, MLA_Q_RANK)),
        "mla_w_uq": nrm((n_mla, MLA_Q_RANK, MLA_HEADS * (MLA_NOPE + MLA_ROPE)), MLA_Q_RANK ** -0.5),
        "mla_w_dkv": nrm((n_mla, D, MLA_KV_RANK + MLA_ROPE), D ** -0.5),
        "mla_kv_norm_g": gain((n_mla, MLA_KV_RANK)),
        "mla_w_ukv": nrm((n_mla, MLA_KV_RANK, MLA_HEADS * (MLA_NOPE + MLA_V)), MLA_KV_RANK ** -0.5),
        "mla_w_o": nrm((n_mla, MLA_HEADS * MLA_V, D), (MLA_HEADS * MLA_V) ** -0.5),
        "fnet_w_o": nrm((n_fnet, D, D), D ** -0.5),
        "ffn_w_in": nrm((DEPTH, D, 2 * F), D ** -0.5),
        "ffn_w_out": nrm((DEPTH, F, D), F ** -0.5),
        "final_norm_g": gain((D,)),
    }


def reference(x, c, ctx, c_ctx, mod_w, mod_b, mix_norm_g, ffn_norm_g, conv_w_in, conv_w,
              conv_w_out, nat_w_qkv, nat_rpb, nat_w_o, mla_w_dq, mla_q_norm_g, mla_w_uq,
              mla_w_dkv, mla_kv_norm_g, mla_w_ukv, mla_w_o, fnet_w_o, ffn_w_in, ffn_w_out,
              final_norm_g):
    S = x.shape[1]
    rope_cos, rope_sin = axial_rope_tables(S, MLA_ROPE)
    silu_c = jax.nn.silu(c)
    silu_cc = jax.nn.silu(c_ctx)
    xl, xc = x, ctx
    for i in range(DEPTH):
        kind, j = i % N_MIXERS, i // N_MIXERS
        reads_ctx = kind in (MIX_NAT, MIX_MLA)
        ctx_needed = any((l % N_MIXERS) in (MIX_NAT, MIX_MLA) for l in range(i + 1, DEPTH))

        mod_l = jnp.split(silu_c @ mod_w[i] + mod_b[i], N_MOD, axis=-1)
        sh1, sc1, g1, sh2, sc2, g2 = [m[:, None, :] for m in mod_l]
        hl = modulate(rmsnorm(xl, mix_norm_g[i]), sh1, sc1)
        hc = None
        if reads_ctx or ctx_needed:
            mc = jnp.split(silu_cc @ mod_w[i] + mod_b[i], N_MOD, axis=-1)
            hc = modulate(rmsnorm(xc, mix_norm_g[i]), mc[0], mc[1])

        if kind == MIX_CONV:
            yl = short_conv_mixer(hl, conv_w_in[j], conv_w[j], conv_w_out[j])
            yc = short_conv_mixer(hc, conv_w_in[j], conv_w[j], conv_w_out[j]) if ctx_needed else None
        elif kind == MIX_NAT:
            yl, yc = neighbourhood_attention(hl, hc, nat_w_qkv[j], nat_rpb[j], nat_w_o[j], ctx_needed)
        elif kind == MIX_MLA:
            yl, yc = latent_attention(hl, hc, mla_w_dq[j], mla_q_norm_g[j], mla_w_uq[j], mla_w_dkv[j],
                                      mla_kv_norm_g[j], mla_w_ukv[j], mla_w_o[j], rope_cos, rope_sin,
                                      ctx_needed)
        else:
            yl = fourier_mixer(hl, fnet_w_o[j])
            yc = fourier_mixer(hc, fnet_w_o[j]) if ctx_needed else None

        xl = xl + g1 * yl
        xl = xl + g2 * swiglu(modulate(rmsnorm(xl, ffn_norm_g[i]), sh2, sc2), ffn_w_in[i], ffn_w_out[i])
        if ctx_needed:
            xc = xc + mc[2] * yc
            xc = xc + mc[5] * swiglu(modulate(rmsnorm(xc, ffn_norm_g[i]), mc[3], mc[4]),
                                     ffn_w_in[i], ffn_w_out[i])
    return rmsnorm(xl, final_norm_g)
```

```cpp
#include <hip/hip_runtime.h>
#include <hip/hip_cooperative_groups.h>
#include <cstdio>
#include <cstdint>
namespace cg = cooperative_groups;

#define LAS __attribute__((address_space(3)))
typedef unsigned short bf16_t;
typedef short bf16x8 __attribute__((ext_vector_type(8)));
typedef float f32x4 __attribute__((ext_vector_type(4)));
typedef float f32x2 __attribute__((ext_vector_type(2)));
typedef float f32x16 __attribute__((ext_vector_type(16)));
typedef unsigned u32x4 __attribute__((ext_vector_type(4)));
typedef unsigned u32x2 __attribute__((ext_vector_type(2)));

__device__ __forceinline__ unsigned cvt_pk_bf16(float lo, float hi) { unsigned r; asm("v_cvt_pk_bf16_f32 %0, %1, %2" : "=v"(r) : "v"(lo), "v"(hi)); return r; }
__device__ __forceinline__ float bf_lo(unsigned w) { return __uint_as_float(w << 16); }
__device__ __forceinline__ float bf_hi(unsigned w) { return __uint_as_float(w & 0xffff0000u); }
__device__ __forceinline__ float silu_f(float v) { return v * __builtin_amdgcn_rcpf(1.0f + __expf(-v)); }
__device__ __forceinline__ float xor32_sum(float v) { const auto rr = __builtin_amdgcn_permlane32_swap(__float_as_uint(v), __float_as_uint(v), false, false); return __uint_as_float(rr[0]) + __uint_as_float(rr[1]); }
__device__ __forceinline__ float xor32_max(float v) { const auto rr = __builtin_amdgcn_permlane32_swap(__float_as_uint(v), __float_as_uint(v), false, false); return fmaxf(__uint_as_float(rr[0]), __uint_as_float(rr[1])); }
#define SWZ_XOR(v, k) __int_as_float(__builtin_amdgcn_ds_swizzle(__float_as_int(v), ((k) << 10) | 0x1f))
__device__ __forceinline__ float wave_sum(float v) {
    v += SWZ_XOR(v, 1); v += SWZ_XOR(v, 2); v += SWZ_XOR(v, 4); v += SWZ_XOR(v, 8); v += SWZ_XOR(v, 16);
    return xor32_sum(v);
}

constexpr int DM = 1024, NB = 4, SEQ = 4096, CTXL = 256, FH = 2816;
constexpr int ML = NB * SEQ;
constexpr int MC = NB * CTXL;
constexpr int MT = ML + MC;
constexpr int NKEY = SEQ + CTXL;
constexpr float LOG2E = 1.4426950408889634f;
constexpr float NORM_EPS = 1e-6f;

__device__ __forceinline__ int mod_row(int r) { return r < ML ? (r >> 12) : 4; }
__device__ __forceinline__ void tok_bk(int t, int& b, int& key) { if (t < ML) { b = t >> 12; key = t & 4095; } else { const int c = t - ML; b = c >> 8; key = SEQ + (c & 255); } }
__device__ __forceinline__ int key_tok(int b, int key) { return key < SEQ ? b * SEQ + key : ML + b * CTXL + (key - SEQ); }

namespace pg8 {
#define PG8_LAS __attribute__((address_space(3)))
constexpr int BM = 256, BK = 64, HALF = 128, HTB = HALF * BK * 2, STAGE_BYTES = 8 * HTB, NXCD = 8, WGM = 8;
__host__ __device__ __forceinline__ int lds_byte(int r, int c) { const int st = (r >> 4) * 2 + (c >> 5), rr = r & 15, cc = c & 31, ob = rr * 64 + cc * 2; return st * 1024 + (ob ^ (((ob >> 9) & 1) << 5)); }
__host__ __device__ __forceinline__ void stage_rc(int b, int& R, int& C) { const int st = b / 1024, sb = b % 1024, swz = sb ^ (((sb >> 9) & 1) << 5); R = (st >> 1) * 16 + swz / 64; C = (st & 1) * 32 + (swz % 64) / 2; }
__host__ __device__ __forceinline__ int perm32(int rho) { const int n = rho >> 4, i = rho & 15; return 8 * (i >> 2) + 4 * n + (i & 3); }

struct Unit { int pm, pn, z; };
struct Gemm { const bf16_t* A; const bf16_t* Bt; int lda, ldb, K; size_t zsA, zsB; };
struct Order {
    int nM, nN, nMz, nwg, G, c;
    __device__ __forceinline__ void init(int nM_, int nN_, int nZ, int G_, int c_) { nM = nM_; nN = nN_; nMz = nM_ * nZ; nwg = nMz * nN; G = G_; c = c_; }
    __device__ __forceinline__ bool next(int i, Unit& u) const {
        const long L = (long)i * G + c; if (c < 0 || L >= nwg) return false;
        int wgid = (int)L; { const int q = nwg / NXCD, r = nwg % NXCD, xcd = wgid % NXCD, off = wgid / NXCD; wgid = (xcd < r ? xcd * (q + 1) : r * (q + 1) + (xcd - r) * q) + off; }
        const int nig = WGM * nN, gid = wgid / nig, fm = gid * WGM, gsz = (nMz - fm) < WGM ? (nMz - fm) : WGM;
        const int pmz = fm + ((wgid % nig) % gsz); u.pn = (wgid % nig) / gsz; u.z = pmz / nM; u.pm = pmz % nM; return true;
    }
    __device__ __forceinline__ void a_ready(const Unit&) const {}
    __device__ __forceinline__ void done(const Unit&) const {}
};

struct StoreEpi {
    static constexpr bool PERM = true, AFTER_DRAIN = false, INIT_ACC = false;
    int mode;
    bf16_t* O0; int ld0; float s0; int split; bf16_t* O1; int ld1; int zrows; int coff;
    __device__ __forceinline__ void operator()(const f32x4 (&acc)[2][2][4][2], const Unit& u, int wr, int wc, int fr, int fq) const {
        if (mode >= 3) {
#pragma unroll
            for (int m = 0; m < 4; ++m) {
                int kq = m * 16 + fr;
                asm volatile("" : "+v"(kq) :: "memory");
#pragma unroll
                for (int bj = 0; bj < 2; ++bj) {
                    const int R = u.pn * BM + bj * HALF + wc * 32 + 8 * fq;
                    if (mode == 3) {
                        const int col = R >> 5, n2 = (R & 31) + 32 * wr, b = col >> 10, colb = col & 1023;
                        bf16_t* p = O0 + ((size_t)((b * 32 + (kq & 31)) * 1024 + colb)) * 256 + (kq >> 5) * 128 + n2;
#pragma unroll
                        for (int nn = 0; nn < 2; ++nn) {
                            const f32x4 a = acc[0][bj][m][nn], bb = acc[1][bj][m][nn]; float tr[4], ti[4];
#pragma unroll
                            for (int i = 0; i < 4; ++i) { const float x = (float)((n2 + 4 * nn + i) * kq) * (1.f / 4096.f); const float ct = __builtin_amdgcn_cosf(x), st = __builtin_amdgcn_sinf(x);
                                tr[i] = a[i] * ct + bb[i] * st; ti[i] = bb[i] * ct - a[i] * st; }
                            u32x2 w; w.x = cvt_pk_bf16(tr[0], tr[1]); w.y = cvt_pk_bf16(tr[2], tr[3]); *(u32x2*)(p + 4 * nn) = w;
                            w.x = cvt_pk_bf16(ti[0], ti[1]); w.y = cvt_pk_bf16(ti[2], ti[3]); *(u32x2*)(p + 64 + 4 * nn) = w;
                            asm volatile("" ::: "memory");
                        }
                    } else {
                        const int b = R >> 15, k1lo = (R >> 10) & 31, colb = R & 1023;
                        const f32x4 v0 = acc[0][bj][m][0], v1 = acc[0][bj][m][1];
                        u32x4 w; w.x = cvt_pk_bf16(v0[0], v0[1]); w.y = cvt_pk_bf16(v0[2], v0[3]); w.z = cvt_pk_bf16(v1[0], v1[1]); w.w = cvt_pk_bf16(v1[2], v1[3]);
                        *(u32x4*)(O0 + (size_t)(b * 4096 + k1lo + 32 * wr + 64 * kq) * 1024 + colb) = w;
                    }
                }
                asm volatile("" ::: "memory");
            }
            return;
        }
#pragma unroll
        for (int ai = 0; ai < 2; ++ai)
#pragma unroll
            for (int m = 0; m < 4; ++m) {
                const int r = u.pm * BM + ai * HALF + wr * 64 + m * 16 + fr;
#pragma unroll
                for (int bj = 0; bj < 2; ++bj) {
                    const int c = u.pn * BM + bj * HALF + wc * 32 + 8 * fq;
                    bf16_t* p; float sc = 1.f;
                    if (mode == 0) { if (c < split) { p = O0 + (size_t)(u.z * zrows + r) * ld0 + c; sc = s0; } else p = O1 + (size_t)r * ld1 + (c - split); }
                    else if (mode == 1) { int b, key; tok_bk(c + coff, b, key); p = O0 + (size_t)(b * DM + r) * NKEY + key; }
                    else { const int ri = r >> 8, k2 = r & 255, b = c >> 12, pp = c & 4095; p = O0 + (size_t)((b * 4 + u.z) * 256 + k2) * 8192 + (pp >> 6) * 128 + ri * 64 + (pp & 63); }
                    const f32x4 v0 = acc[ai][bj][m][0] * sc, v1 = acc[ai][bj][m][1] * sc;
                    u32x4 w; w.x = cvt_pk_bf16(v0[0], v0[1]); w.y = cvt_pk_bf16(v0[2], v0[3]); w.z = cvt_pk_bf16(v1[0], v1[1]); w.w = cvt_pk_bf16(v1[2], v1[3]);
                    *(u32x4*)p = w;
                }
                asm volatile("" ::: "memory");
            }
    }
};
struct PairEpi {
    static constexpr bool PERM = true, AFTER_DRAIN = false, INIT_ACC = false;
    int act;
    int pn0; bf16_t* O0; int ld0; bf16_t* O1; int ld1;
    int fuse; const float* rowss; const float* shw;
    __device__ __forceinline__ void operator()(const f32x4 (&acc)[2][2][4][2], const Unit& u, int wr, int wc, int fr, int fq) const {
        if (u.pn < pn0) {
#pragma unroll
            for (int ai = 0; ai < 2; ++ai)
#pragma unroll
                for (int m = 0; m < 4; ++m) {
                    const int r = u.pm * BM + ai * HALF + wr * 64 + m * 16 + fr;
#pragma unroll
                    for (int bj = 0; bj < 2; ++bj) {
                        const int c = u.pn * BM + bj * HALF + wc * 32 + 8 * fq;
                        const f32x4 v0 = acc[ai][bj][m][0], v1 = acc[ai][bj][m][1];
                        u32x4 w; w.x = cvt_pk_bf16(v0[0], v0[1]); w.y = cvt_pk_bf16(v0[2], v0[3]); w.z = cvt_pk_bf16(v1[0], v1[1]); w.w = cvt_pk_bf16(v1[2], v1[3]);
                        *(u32x4*)(O0 + (size_t)r * ld0 + c) = w;
                    }
                    asm volatile("" ::: "memory");
                }
        } else {
            const int c = (u.pn - pn0) * HALF + wc * 32 + 8 * fq;
            f32x4 shg[2], shu[2];
            if (fuse) { const int r0 = u.pm * BM; const float* sp = shw + (r0 < ML ? (r0 >> 12) : 5) * (2 * FH) + u.pn * BM + wc * 32 + 8 * fq;
                shg[0] = *(const f32x4*)sp; shg[1] = *(const f32x4*)(sp + 4); shu[0] = *(const f32x4*)(sp + HALF); shu[1] = *(const f32x4*)(sp + HALF + 4); }
            float rsv[2][4];
#pragma unroll
            for (int ai = 0; ai < 2; ++ai)
#pragma unroll
                for (int m = 0; m < 4; ++m) { const int r = u.pm * BM + ai * HALF + wr * 64 + m * 16 + fr; rsv[ai][m] = (fuse && r < ML) ? rowss[r] : 0.f; }
#pragma unroll
            for (int ai = 0; ai < 2; ++ai)
#pragma unroll
                for (int m = 0; m < 4; ++m) rsv[ai][m] = (fuse && u.pm * BM < ML) ? rsqrtf(rsv[ai][m] * (1.f / DM) + NORM_EPS) : 1.f;
#pragma unroll
            for (int ai = 0; ai < 2; ++ai)
#pragma unroll
                for (int m = 0; m < 4; ++m) {
                    const int r = u.pm * BM + ai * HALF + wr * 64 + m * 16 + fr;
                    const float rs = rsv[ai][m];
                    f32x4 v[2];
#pragma unroll
                    for (int n = 0; n < 2; ++n) {
                        f32x4 a = acc[ai][0][m][n], b = acc[ai][1][m][n];
                        if (fuse) { a = a * rs + shg[n]; b = b * rs + shu[n]; }
                        if (act == 1) { v[n] = (f32x4){silu_f(a[0]) * b[0], silu_f(a[1]) * b[1], silu_f(a[2]) * b[2], silu_f(a[3]) * b[3]}; }
                        else v[n] = a * b;
                    }
                    u32x4 w; w.x = cvt_pk_bf16(v[0][0], v[0][1]); w.y = cvt_pk_bf16(v[0][2], v[0][3]); w.z = cvt_pk_bf16(v[1][0], v[1][1]); w.w = cvt_pk_bf16(v[1][2], v[1][3]);
                    *(u32x4*)(O1 + (size_t)r * ld1 + c) = w;
                    asm volatile("" ::: "memory");
                }
        }
    }
};
struct ResidEpi {
    static constexpr bool PERM = false, AFTER_DRAIN = false, INIT_ACC = true;
    __device__ __forceinline__ static f32x4 gclamp(f32x4 g) { f32x4 r;
#pragma unroll
        for (int i = 0; i < 4; ++i) r[i] = fabsf(g[i]) < 1e-12f ? 1e-12f : g[i];
        return r; }
    __device__ __forceinline__ void init(f32x4 (&acc)[2][2][4][2], const Unit& u, int wr, int wc, int fr, int fq, float zf) const {
        if (atomic) {
#pragma unroll
            for (int a = 0; a < 2; ++a)
#pragma unroll
                for (int b = 0; b < 2; ++b)
#pragma unroll
                    for (int m = 0; m < 4; ++m)
#pragma unroll
                        for (int n = 0; n < 2; ++n) acc[a][b][m][n] = (f32x4){zf, zf, zf, zf};
            return;
        }
        const int mr = mod_row(rbase + u.pm * BM);
#pragma unroll
        for (int ai = 0; ai < 2; ++ai)
#pragma unroll
            for (int m = 0; m < 4; ++m) { const int r = rbase + u.pm * BM + ai * HALF + wr * 64 + m * 16 + fr;
                const float* s = r < ML ? srcL + (size_t)r * DM : srcC + (size_t)(r - ML) * DM;
#pragma unroll
                for (int bj = 0; bj < 2; ++bj)
#pragma unroll
                    for (int n = 0; n < 2; ++n) acc[ai][bj][m][n] = *(const f32x4*)(s + u.pn * BM + bj * HALF + wc * 32 + 16 * n + 4 * fq); }
#pragma unroll
        for (int bj = 0; bj < 2; ++bj)
#pragma unroll
            for (int n = 0; n < 2; ++n) { const f32x4 gc = gclamp(*(const f32x4*)(gate + mr * 6144 + u.pn * BM + bj * HALF + wc * 32 + 16 * n + 4 * fq));
                const f32x4 gi = (f32x4){1.0f / gc[0], 1.0f / gc[1], 1.0f / gc[2], 1.0f / gc[3]};
#pragma unroll
                for (int ai = 0; ai < 2; ++ai)
#pragma unroll
                    for (int m = 0; m < 4; ++m) acc[ai][bj][m][n] *= gi; }
    }
    const float* srcL; const float* srcC; float* dstL; float* dstC; const float* gate;
    int rbase, atomic; float* part;
    int fuse; bf16_t* Hn; const float* g2; const float* sc2; float* rowss;
    __device__ __forceinline__ void operator()(const f32x4 (&acc)[2][2][4][2], const Unit& u, int wr, int wc, int fr, int fq) const {
        const int mr = mod_row(rbase + u.pm * BM);
        f32x4 gv[2][2], gm[2][2];
#pragma unroll
        for (int bj = 0; bj < 2; ++bj)
#pragma unroll
            for (int n = 0; n < 2; ++n) { const int c = u.pn * BM + bj * HALF + wc * 32 + 16 * n + 4 * fq;
                gv[bj][n] = gclamp(*(const f32x4*)(gate + mr * 6144 + c));
                gm[bj][n] = fuse ? *(const f32x4*)(g2 + c) * (*(const f32x4*)(sc2 + mr * 6144 + c) + 1.0f) : gv[bj][n]; }
#pragma unroll
        for (int ai = 0; ai < 2; ++ai)
#pragma unroll
            for (int m = 0; m < 4; ++m) {
                const int r = rbase + u.pm * BM + ai * HALF + wr * 64 + m * 16 + fr;
                const float* s = r < ML ? srcL + (size_t)r * DM : srcC + (size_t)(r - ML) * DM;
                float* d = r < ML ? dstL + (size_t)r * DM : dstC + (size_t)(r - ML) * DM;
                float ss = 0.f;
#pragma unroll
                for (int bj = 0; bj < 2; ++bj)
#pragma unroll
                    for (int n = 0; n < 2; ++n) {
                        const int c = u.pn * BM + bj * HALF + wc * 32 + 16 * n + 4 * fq;
                        if (atomic) { *(f32x4*)(part + ((size_t)(u.z * MC + (r - ML)) * DM + c)) = acc[ai][bj][m][n]; }
                        else {
                            const f32x4 xn = gv[bj][n] * acc[ai][bj][m][n]; *(f32x4*)(d + c) = xn;
                            if (fuse) { ss += (xn[0] * xn[0] + xn[1] * xn[1]) + (xn[2] * xn[2] + xn[3] * xn[3]); const f32x4 xg = xn * gm[bj][n];
                                u32x2 w; w.x = cvt_pk_bf16(xg[0], xg[1]); w.y = cvt_pk_bf16(xg[2], xg[3]); *(u32x2*)(Hn + (size_t)r * DM + c) = w; }
                        }
                    }
                if (fuse) { ss += SWZ_XOR(ss, 16); ss = xor32_sum(ss); if (fq == 0) unsafeAtomicAdd(rowss + r, ss); }
                if (fuse && (m & 1)) asm volatile("" ::: "memory");
            }
    }
};

template <class Epi, class Sched, bool ALIGN_EPI = false, bool SP2 = false>
__device__ __forceinline__ void gemm_phase(PG8_LAS unsigned char* lds, const Gemm g, const Sched& S, const Epi& E, const int tid) {
    const int wid = __builtin_amdgcn_readfirstlane(tid >> 6), lane = tid & 63, wr = wid >> 2, wc = wid & 3, fr = lane & 15, fq = lane >> 4;
    const int K = g.K, nt = K / BK, lda = g.lda, ldb = g.ldb;
    unsigned voffA[2], voffB[2];
#pragma unroll
    for (int i = 0; i < 2; ++i) { int R, C; stage_rc(tid * 16 + i * 8192, R, C); const int Rb = Epi::PERM ? ((R & ~31) + perm32(R & 31)) : R;
        voffA[i] = (unsigned)(R * lda + C) * 2u; voffB[i] = (unsigned)(Rb * ldb + C) * 2u; }
    const size_t kstep = (size_t)(BK * 2);
    const size_t hstepA = (size_t)HALF * lda * 2, hstepB = (size_t)HALF * ldb * 2;
    const size_t tstepA = 2 * hstepA, tstepB = 2 * hstepB;
    const unsigned ldsw = (unsigned)wid * 1024u;
    const int aoff = lds_byte(wr * 64 + fr, fq * 8), boff = lds_byte(wc * 32 + fr, fq * 8);
#define PG8_SA(b, h) (((b) * 2 + (h)) * HTB)
#define PG8_SB(b, h) ((4 + (b) * 2 + (h)) * HTB)
#define PG8_STAGE(bufoff, gbase, voff) do { _Pragma("unroll") for (int _i = 0; _i < 2; ++_i) \
        __builtin_amdgcn_global_load_lds((const unsigned*)((const char*)(gbase) + (voff)[_i]), (PG8_LAS unsigned*)(lds + (bufoff) + ldsw + _i * 8192), 16, 0, 0); } while (0)
#define PG8_LDA(dst, b, h) do { _Pragma("unroll") for (int m = 0; m < 4; ++m) _Pragma("unroll") for (int k = 0; k < 2; ++k) dst[m][k] = *(const PG8_LAS bf16x8*)(lds + PG8_SA(b, h) + aoff + m * 2048 + k * 1024); } while (0)
#define PG8_LDB(dst, b, h) do { _Pragma("unroll") for (int n = 0; n < 2; ++n) _Pragma("unroll") for (int k = 0; k < 2; ++k) dst[n][k] = *(const PG8_LAS bf16x8*)(lds + PG8_SB(b, h) + boff + n * 2048 + k * 1024); } while (0)
#define PG8_MMA(ai, bj, At, Bt) do { __builtin_amdgcn_s_setprio(1); _Pragma("unroll") for (int m = 0; m < 4; ++m) _Pragma("unroll") for (int n = 0; n < 2; ++n) _Pragma("unroll") for (int k = 0; k < 2; ++k) \
        acc[ai][bj][m][n] = __builtin_amdgcn_mfma_f32_16x16x32_bf16(Bt[n][k], At[m][k], acc[ai][bj][m][n], 0, 0, 0); __builtin_amdgcn_s_setprio(0); } while (0)
#define PG8_WAIT_V(n) asm volatile("s_waitcnt vmcnt(" #n ")" ::: "memory")
#define PG8_WAIT_L(n) asm volatile("s_waitcnt lgkmcnt(" #n ")" ::: "memory")
#define PG8_BAR __builtin_amdgcn_s_barrier()
#define PG8_SCHED __builtin_amdgcn_sched_barrier(0)
    Unit cur, nxt; int ui = 0;
    if (!S.next(0, cur)) return;
    float zf_ = 0.f; asm volatile("" : "+v"(zf_));
    f32x4 acc[2][2][4][2];
    if constexpr (Epi::INIT_ACC) E.init(acc, cur, wr, wc, fr, fq, zf_);
    else {
#pragma unroll
    for (int a = 0; a < 2; ++a)
#pragma unroll
        for (int b = 0; b < 2; ++b)
#pragma unroll
            for (int m = 0; m < 4; ++m)
#pragma unroll
                for (int n = 0; n < 2; ++n) acc[a][b][m][n] = (f32x4){zf_, zf_, zf_, zf_};
    }
    bf16x8 At[4][2], B0[2][2], B1[2][2];
    const char* cA = (const char*)g.A + (size_t)cur.z * g.zsA + (size_t)cur.pm * tstepA; const char* cB = (const char*)g.Bt + (size_t)cur.z * g.zsB + (size_t)cur.pn * tstepB;
    S.a_ready(cur);
    if constexpr (SP2) {
        PG8_STAGE(PG8_SB(0, 0), cB, voffB); PG8_STAGE(PG8_SB(0, 1), cB + hstepB, voffB); PG8_STAGE(PG8_SA(0, 0), cA, voffA); PG8_STAGE(PG8_SA(0, 1), cA + hstepA, voffA);
        if (wr == 1) PG8_BAR;
        PG8_WAIT_V(2); PG8_BAR;
        PG8_STAGE(PG8_SB(1, 0), cB + kstep, voffB); PG8_STAGE(PG8_SA(1, 0), cA + kstep, voffA); PG8_STAGE(PG8_SB(1, 1), cB + hstepB + kstep, voffB);
        PG8_WAIT_V(6); PG8_BAR;
    } else {
        PG8_STAGE(PG8_SB(0, 0), cB, voffB); PG8_STAGE(PG8_SA(0, 0), cA, voffA); PG8_STAGE(PG8_SB(0, 1), cB + hstepB, voffB); PG8_STAGE(PG8_SA(0, 1), cA + hstepA, voffA);
        if (wr == 1) PG8_BAR;
        PG8_WAIT_V(4); PG8_BAR;
        PG8_STAGE(PG8_SB(1, 0), cB + kstep, voffB); PG8_STAGE(PG8_SA(1, 0), cA + kstep, voffA); PG8_STAGE(PG8_SB(1, 1), cB + hstepB + kstep, voffB);
        PG8_WAIT_V(6); PG8_BAR;
    }
    for (;;) {
        const bool has_next = S.next(ui + 1, nxt);
        const char* nA = has_next ? (const char*)g.A + (size_t)nxt.z * g.zsA + (size_t)nxt.pm * tstepA : cA; const char* nB = has_next ? (const char*)g.Bt + (size_t)nxt.z * g.zsB + (size_t)nxt.pn * tstepB : cB;
        for (int t = 0; t < nt; t += 2) {
            const bool last = (t == nt - 2);
            const char* a1 = cA + (size_t)(t + 1) * kstep;
            const char* a2 = last ? nA : cA + (size_t)(t + 2) * kstep; const char* b2 = last ? nB : cB + (size_t)(t + 2) * kstep;
            const char* a3 = a2 + kstep; const char* b3 = b2 + kstep;
            if (last && has_next) S.a_ready(nxt);
            if constexpr (SP2) {
            PG8_LDB(B0, 0, 0); PG8_LDB(B1, 0, 1); PG8_SCHED; PG8_LDA(At, 0, 0); PG8_STAGE(PG8_SA(1, 1), a1 + hstepA, voffA);
            PG8_WAIT_V(8); PG8_WAIT_L(0); PG8_BAR; PG8_MMA(0, 0, At, B0); PG8_MMA(0, 1, At, B1); PG8_BAR; PG8_SCHED;
            PG8_LDA(At, 0, 1); PG8_STAGE(PG8_SB(0, 0), b2, voffB); PG8_STAGE(PG8_SB(0, 1), b2 + hstepB, voffB); PG8_STAGE(PG8_SA(0, 0), a2, voffA);
            PG8_WAIT_V(8); PG8_WAIT_L(0); PG8_BAR; PG8_MMA(1, 0, At, B0); PG8_MMA(1, 1, At, B1); PG8_BAR; PG8_SCHED;
            PG8_LDB(B0, 1, 0); PG8_LDB(B1, 1, 1); PG8_SCHED; PG8_LDA(At, 1, 0); PG8_STAGE(PG8_SA(0, 1), a2 + hstepA, voffA);
            PG8_WAIT_V(8); PG8_WAIT_L(0); PG8_BAR; PG8_MMA(0, 0, At, B0); PG8_MMA(0, 1, At, B1); PG8_BAR; PG8_SCHED;
            PG8_LDA(At, 1, 1); PG8_STAGE(PG8_SB(1, 0), b3, voffB); PG8_STAGE(PG8_SB(1, 1), b3 + hstepB, voffB); PG8_STAGE(PG8_SA(1, 0), a3, voffA);
            PG8_WAIT_V(8); PG8_WAIT_L(0); PG8_BAR; PG8_MMA(1, 0, At, B0); PG8_MMA(1, 1, At, B1); PG8_BAR; PG8_SCHED;
            } else {
            PG8_LDB(B0, 0, 0); PG8_SCHED; PG8_LDA(At, 0, 0); PG8_STAGE(PG8_SA(1, 1), a1 + hstepA, voffA);
            PG8_WAIT_L(8); PG8_BAR; PG8_WAIT_L(0); PG8_MMA(0, 0, At, B0); PG8_BAR; PG8_SCHED;
            PG8_LDB(B1, 0, 1); PG8_STAGE(PG8_SB(0, 0), b2, voffB);
            PG8_BAR; PG8_WAIT_L(0); PG8_MMA(0, 1, At, B1); PG8_BAR;
            PG8_LDA(At, 0, 1); PG8_STAGE(PG8_SA(0, 0), a2, voffA);
            PG8_BAR; PG8_WAIT_L(0); PG8_MMA(1, 0, At, B0); PG8_BAR; PG8_SCHED;
            PG8_STAGE(PG8_SB(0, 1), b2 + hstepB, voffB);
            PG8_WAIT_V(6); PG8_BAR; PG8_MMA(1, 1, At, B1); PG8_BAR;
            PG8_LDB(B0, 1, 0); PG8_SCHED; PG8_LDA(At, 1, 0); PG8_STAGE(PG8_SA(0, 1), a2 + hstepA, voffA);
            PG8_WAIT_L(8); PG8_BAR; PG8_WAIT_L(0); PG8_MMA(0, 0, At, B0); PG8_BAR; PG8_SCHED;
            PG8_LDB(B1, 1, 1); PG8_STAGE(PG8_SB(1, 0), b3, voffB);
            PG8_BAR; PG8_WAIT_L(0); PG8_MMA(0, 1, At, B1); PG8_BAR;
            PG8_LDA(At, 1, 1); PG8_STAGE(PG8_SA(1, 0), a3, voffA);
            PG8_BAR; PG8_WAIT_L(0); PG8_MMA(1, 0, At, B0); PG8_BAR; PG8_SCHED;
            PG8_STAGE(PG8_SB(1, 1), b3 + hstepB, voffB);
            PG8_WAIT_V(6); PG8_BAR; PG8_MMA(1, 1, At, B1); PG8_BAR;
            }
        }
        if constexpr (ALIGN_EPI) { if (wr == 0) PG8_BAR; }
        if constexpr (!Epi::AFTER_DRAIN) { E(acc, cur, wr, wc, fr, fq); S.done(cur); }
        if (!has_next) break;
        if constexpr (Epi::INIT_ACC) E.init(acc, nxt, wr, wc, fr, fq, zf_);
        else {
#pragma unroll
        for (int a = 0; a < 2; ++a)
#pragma unroll
            for (int b = 0; b < 2; ++b)
#pragma unroll
                for (int m = 0; m < 4; ++m)
#pragma unroll
                    for (int n = 0; n < 2; ++n) acc[a][b][m][n] = (f32x4){zf_, zf_, zf_, zf_};
        }
        cur = nxt; cA = nA; cB = nB; ++ui;
        if constexpr (ALIGN_EPI) { if (wr == 1) PG8_BAR; }
    }
    PG8_WAIT_V(0);
    if constexpr (!ALIGN_EPI) { if (wr == 0) PG8_BAR; }
    PG8_BAR;
    if constexpr (Epi::AFTER_DRAIN) { E.fused(acc, cur, wr, wc, fr, fq, lds, wid, lane); S.done(cur); }
#undef PG8_SA
#undef PG8_SB
#undef PG8_STAGE
#undef PG8_LDA
#undef PG8_LDB
#undef PG8_MMA
#undef PG8_WAIT_V
#undef PG8_WAIT_L
#undef PG8_BAR
#undef PG8_SCHED
}
}

constexpr size_t MiB = (size_t)1 << 20;
constexpr size_t WS_MOD = 0;
constexpr size_t WS_ROPE = 1 * MiB;
constexpr size_t WS_DFTA = 2 * MiB;
constexpr size_t WS_KR = 3 * MiB;
constexpr size_t WS_XC = 5 * MiB;
constexpr size_t WS_CONV_IN = 9 * MiB, WS_CONV_OUT = 15 * MiB, WS_NAT_QK = 17 * MiB, WS_NAT_V = 21 * MiB, WS_NAT_O = 23 * MiB;
constexpr size_t WS_MLA_A = 25 * MiB, WS_MLA_UQ = 27 * MiB, WS_MLA_K = 28 * MiB, WS_MLA_V = 29 * MiB, WS_MLA_O = 30 * MiB, WS_FNET_O = 32 * MiB;
constexpr size_t WS_FFN_IN = 34 * MiB, FFN_IN_STRIDE = 11 * MiB, WS_FFN_OUT = 78 * MiB, FFN_OUT_STRIDE = (size_t)DM * FH * 2;
constexpr size_t WS_DFTB = 100 * MiB;
constexpr size_t WS_H = 164 * MiB;
constexpr size_t WS_BIG = 198 * MiB;
constexpr size_t WS_ZG = 300 * MiB;
constexpr size_t WS_VT = 334 * MiB;
constexpr size_t WS_SHW = 368 * MiB;
constexpr size_t WS_END = 369 * MiB;
constexpr size_t WS_ROWSS = 576 * 1024;
constexpr size_t SUB = 34 * MiB;

struct Params {
    const float* in[25];
    float* out; unsigned char* ws;
    int ph_lo, ph_hi;
};
enum { I_X = 0, I_C, I_CTX, I_CCTX, I_MODW, I_MODB, I_MIXG, I_FFNG, I_CONV_IN, I_CONV_W, I_CONV_OUT, I_NAT_QKV, I_NAT_RPB, I_NAT_O,
       I_MLA_DQ, I_MLA_QG, I_MLA_UQ, I_MLA_DKV, I_MLA_KVG, I_MLA_UKV, I_MLA_O, I_FNET_O, I_FFN_IN, I_FFN_OUT, I_FINAL_G };

__device__ __forceinline__ unsigned f2bf(float f) { unsigned u = __float_as_uint(f); return (u + 0x7fffu + ((u >> 16) & 1u)) >> 16; }
__device__ __forceinline__ unsigned pk2(float lo, float hi) { return f2bf(lo) | (f2bf(hi) << 16); }

struct TrItem { const float* src; bf16_t* dst; int N, K; };
__device__ __forceinline__ TrItem transpose_decode(const float* W, int K, int N, int kind, bf16_t* D0, bf16_t* D1, int item) {
    const int nblk = N / 32, kb = item / nblk, nb = item % nblk, k0 = 64 * kb, n0 = 32 * nb;
    bf16_t* D = D0; int drow = n0;
    if (kind == 1) { const int j = n0 < FH ? n0 : n0 - FH; drow = 256 * (j / 128) + (j % 128) + (n0 < FH ? 0 : 128); }
    else if (kind == 2) { if (n0 >= 1024) { const int j = (n0 - 1024) & 1023; drow = 1024 + 256 * (j / 128) + (j % 128) + (n0 >= 2048 ? 128 : 0); } }
    else if (kind == 3) { if (n0 >= 2048) { D = D1; drow = n0 - 2048; } }
    else if (kind == 6) { const int hh = n0 / 96, t = (n0 % 96) / 32; drow = t < 2 ? hh * 64 + 32 * t : 1024 + hh * 32; }
    else if (kind == 7) { const int hh = n0 / 128, j = n0 % 128; if (j < 64) drow = hh * 64 + j; else { D = D1; drow = hh * 64 + j - 64; } }
    TrItem t; t.src = W + (size_t)k0 * N + n0; t.dst = D + (size_t)drow * K + k0; t.N = N; t.K = K; return t;
}
__device__ __forceinline__ void transpose_load(const TrItem& t, float (&wv)[32], int lane) {
#pragma unroll
    for (int i = 0; i < 32; ++i) wv[i] = __builtin_nontemporal_load(t.src + (size_t)(2 * i + (lane >> 5)) * t.N + (lane & 31));
}
__device__ __forceinline__ void transpose_finish(const TrItem& t, const float (&wv)[32], LAS float* scr, int lane) {
#pragma unroll
    for (int i = 0; i < 32; ++i) scr[(2 * i + (lane >> 5)) * 33 + (lane & 31)] = wv[i];
    asm volatile("s_waitcnt lgkmcnt(0)" ::: "memory");
    const int c = lane & 7;
#pragma unroll
    for (int j = 0; j < 4; ++j) { const int n = (lane >> 3) + 8 * j; const LAS float* s = scr + (8 * c) * 33 + n;
        u32x4 o; o.x = pk2(s[0 * 33], s[1 * 33]); o.y = pk2(s[2 * 33], s[3 * 33]); o.z = pk2(s[4 * 33], s[5 * 33]); o.w = pk2(s[6 * 33], s[7 * 33]);
        *(u32x4*)(t.dst + (size_t)n * t.K + 8 * c) = o; }
    asm volatile("s_waitcnt lgkmcnt(0)" ::: "memory");
}

__device__ __forceinline__ void prep_phase(const Params& p, unsigned char* ws, LAS unsigned char* lds, int G, int bid, int tid, int wid, int lane) {
    if (bid < 192) {
        LAS float* sc = (LAS float*)lds;
        LAS float* red = (LAS float*)(lds + 20480);
        for (int idx = tid; idx < 5 * 1024; idx += 512) { const int r = idx >> 10, k = idx & 1023; const float v = r < 4 ? p.in[I_C][r * 1024 + k] : p.in[I_CCTX][k]; sc[idx] = silu_f(v); }
        __syncthreads();
        const int layer = bid / 48, chunk = bid % 48;
        const float* W = p.in[I_MODW] + (size_t)layer * 1024 * 6144 + chunk * 128 + 2 * lane;
        float a[5][2];
#pragma unroll
        for (int r = 0; r < 5; ++r) { a[r][0] = 0.f; a[r][1] = 0.f; }
        const int kbeg = wid * 128;
        for (int k0 = kbeg; k0 < kbeg + 128; k0 += 32) {
            f32x2 w[32];
#pragma unroll
            for (int i = 0; i < 32; ++i) w[i] = __builtin_nontemporal_load((const f32x2*)(W + (size_t)(k0 + i) * 6144));
#pragma unroll
            for (int i = 0; i < 32; ++i)
#pragma unroll
                for (int r = 0; r < 5; ++r) { const float s = sc[r * 1024 + k0 + i]; a[r][0] += s * w[i].x; a[r][1] += s * w[i].y; }
        }
#pragma unroll
        for (int r = 0; r < 5; ++r) { red[(wid * 5 + r) * 128 + 2 * lane] = a[r][0]; red[(wid * 5 + r) * 128 + 2 * lane + 1] = a[r][1]; }
        __syncthreads();
        for (int idx = tid; idx < 640; idx += 512) {
            const int r = idx >> 7, cc = idx & 127; float s = 0.f;
#pragma unroll
            for (int w = 0; w < 8; ++w) s += red[(w * 5 + r) * 128 + cc];
            const int col = chunk * 128 + cc;
            ((float*)(ws + WS_MOD))[(layer * 5 + r) * 6144 + col] = s + p.in[I_MODB][layer * 6144 + col];
        }
        __syncthreads();
    }
    {
        LAS float* scr = (LAS float*)(lds + wid * 16384);
        const int gw = bid * 8 + wid, NGW = G * 8;
        constexpr int IT_CONV_IN = 16 * 96, IT_SQ = 16 * 32, IT_DQ = 16 * 8, IT_DKV = 16 * 9, IT_UQ = 4 * 48, IT_UKV = 4 * 64, IT_FIN = 16 * 176, IT_FOUT = 44 * 32;
        constexpr int NITEMS = IT_CONV_IN + IT_SQ + IT_CONV_IN + IT_SQ + IT_DQ + IT_DKV + IT_UQ + IT_UKV + IT_SQ + IT_SQ + 4 * IT_FIN + 4 * IT_FOUT;
#define DECODE_ITEM(it_, T_) do { const int it = (it_); \
            int r = it; const float* W; int K, N, kind = 0; bf16_t* D0; bf16_t* D1 = nullptr; \
            if (r < IT_CONV_IN) { W = p.in[I_CONV_IN]; K = 1024; N = 3072; kind = 2; D0 = (bf16_t*)(ws + WS_CONV_IN); } \
            else if ((r -= IT_CONV_IN) < IT_SQ) { W = p.in[I_CONV_OUT]; K = 1024; N = 1024; D0 = (bf16_t*)(ws + WS_CONV_OUT); } \
            else if ((r -= IT_SQ) < IT_CONV_IN) { W = p.in[I_NAT_QKV]; K = 1024; N = 3072; kind = 3; D0 = (bf16_t*)(ws + WS_NAT_QK); D1 = (bf16_t*)(ws + WS_NAT_V); } \
            else if ((r -= IT_CONV_IN) < IT_SQ) { W = p.in[I_NAT_O]; K = 1024; N = 1024; D0 = (bf16_t*)(ws + WS_NAT_O); } \
            else if ((r -= IT_SQ) < IT_DQ) { W = p.in[I_MLA_DQ]; K = 1024; N = 256; D0 = (bf16_t*)(ws + WS_MLA_A); } \
            else if ((r -= IT_DQ) < IT_DKV) { W = p.in[I_MLA_DKV]; K = 1024; N = 288; D0 = (bf16_t*)(ws + WS_MLA_A) + 256 * 1024; } \
            else if ((r -= IT_DKV) < IT_UQ) { W = p.in[I_MLA_UQ]; K = 256; N = 1536; kind = 6; D0 = (bf16_t*)(ws + WS_MLA_UQ); } \
            else if ((r -= IT_UQ) < IT_UKV) { W = p.in[I_MLA_UKV]; K = 256; N = 2048; kind = 7; D0 = (bf16_t*)(ws + WS_MLA_K); D1 = (bf16_t*)(ws + WS_MLA_V); } \
            else if ((r -= IT_UKV) < IT_SQ) { W = p.in[I_MLA_O]; K = 1024; N = 1024; D0 = (bf16_t*)(ws + WS_MLA_O); } \
            else if ((r -= IT_SQ) < IT_SQ) { W = p.in[I_FNET_O]; K = 1024; N = 1024; D0 = (bf16_t*)(ws + WS_FNET_O); } \
            else if ((r -= IT_SQ) < 4 * IT_FIN) { const int l = r / IT_FIN; r -= l * IT_FIN; W = p.in[I_FFN_IN] + (size_t)l * 1024 * 5632; K = 1024; N = 5632; kind = 1; D0 = (bf16_t*)(ws + WS_FFN_IN + l * FFN_IN_STRIDE); } \
            else { r -= 4 * IT_FIN; const int l = r / IT_FOUT; r -= l * IT_FOUT; W = p.in[I_FFN_OUT] + (size_t)l * FH * 1024; K = FH; N = 1024; D0 = (bf16_t*)(ws + WS_FFN_OUT + l * FFN_OUT_STRIDE); } \
            T_ = transpose_decode(W, K, N, kind, D0, D1, r); } while (0)
        float wvA[32], wvB[32]; TrItem tA, tB; tB = TrItem{nullptr, nullptr, 0, 0};
        if (gw < NITEMS) { DECODE_ITEM(gw, tA); transpose_load(tA, wvA, lane); }
        for (int it0 = gw; it0 < NITEMS; it0 += NGW) {
            const bool hasn = it0 + NGW < NITEMS;
            if (hasn) { DECODE_ITEM(it0 + NGW, tB); transpose_load(tB, wvB, lane); }
            transpose_finish(tA, wvA, scr, lane);
            if (hasn) { tA = tB;
#pragma unroll
                for (int i = 0; i < 32; ++i) wvA[i] = wvB[i]; }
        }
#undef DECODE_ITEM
    }
    const int gt = bid * 512 + tid, NGT = G * 512;
    { const f32x4* s4 = (const f32x4*)p.in[I_CTX]; f32x4* d4 = (f32x4*)(ws + WS_XC); for (int i = gt; i < MC * DM / 4; i += NGT) d4[i] = s4[i]; }
    { float* z = (float*)(ws + WS_ROWSS); for (int i = gt; i < 4 * ML; i += NGT) z[i] = 0.f; }
    { u32x4* z = (u32x4*)((bf16_t*)(ws + WS_MLA_A) + 544 * 1024); unsigned zu_ = 0u; asm volatile("" : "+v"(zu_)); for (int i = gt; i < 224 * 1024 / 8; i += NGT) z[i] = (u32x4){zu_, zu_, zu_, zu_}; }
    { bf16_t* A = (bf16_t*)(ws + WS_DFTA);
      for (int i = gt; i < 512 * 256; i += NGT) { const int f = i >> 8, c = i & 255, k2 = f & 255, ph = (c * k2) & 255; const float x = (float)ph * (1.f / 256.f);
          const float v = f < 256 ? __builtin_amdgcn_cosf(x) * 0.0625f : -__builtin_amdgcn_sinf(x) * 0.0625f; A[i] = (bf16_t)f2bf(v); } }
    { bf16_t* M1 = (bf16_t*)(ws + WS_DFTA) + 512 * 256; bf16_t* M2 = M1 + 256 * 256;
      for (int i = gt; i < 256 * 256; i += NGT) { const int rho = i >> 8, kap = i & 255; const int ro = rho >> 7, hh = (rho >> 6) & 1, ko = rho & 63, hf = kap >> 7, ri = (kap >> 6) & 1, ni = kap & 63;
          const float x = (float)((ni * ko) & 63) * (1.f / 64.f); const float c = __builtin_amdgcn_cosf(x) * 0.125f, s = __builtin_amdgcn_sinf(x) * 0.125f;
          const float v1 = hf != hh ? 0.f : (ro == 0 ? (ri == 0 ? c : s) : (ri == 0 ? -s : c));
          const float v2 = (hf != hh || ro != 0) ? 0.f : (ri == 0 ? c : s);
          M1[i] = (bf16_t)f2bf(v1); M2[i] = (bf16_t)f2bf(v2); } }
    { float* ct = (float*)(ws + WS_ROPE); float* st = ct + 4096 * 16;
      for (int i = gt; i < 4096 * 16; i += NGT) { const int pos = i >> 4, j = i & 15; const float fr = __builtin_amdgcn_exp2f(-(float)(j & 7) * 1.6609640474436812f);
          const float coord = (float)(j < 8 ? (pos >> 6) : (pos & 63)); const float rev = coord * fr * 0.15915494309189535f; ct[i] = __builtin_amdgcn_cosf(rev); st[i] = __builtin_amdgcn_sinf(rev); } }
}

__device__ __forceinline__ void norm_phase(const float* srcL, const float* srcC, int nrows, const float* g, const float* mod, int sh_off, int sc_off, bf16_t* H,
                                           const float* part, int npart, const float* pgate, float* XCw, int perm, int rbeg, int gw, int NGW, int lane) {
    for (int r0 = rbeg + gw; r0 < nrows; r0 += 2 * NGW) {
        const int r1 = r0 + NGW; const bool has1 = r1 < nrows;
        const float* xr0 = r0 < ML ? srcL + (size_t)r0 * DM : srcC + (size_t)(r0 - ML) * DM;
        const int r1c = has1 ? r1 : r0;
        const float* xr1 = r1c < ML ? srcL + (size_t)r1c * DM : srcC + (size_t)(r1c - ML) * DM;
        f32x4 v[2][4];
#pragma unroll
        for (int j = 0; j < 4; ++j) { v[0][j] = *(const f32x4*)(xr0 + (64 * j + lane) * 4); v[1][j] = *(const f32x4*)(xr1 + (64 * j + lane) * 4); }
#pragma unroll
        for (int q = 0; q < 2; ++q) {
            const int r = q ? r1c : r0;
            if (q == 1 && !has1) break;
            if (r >= ML && npart > 0) {
                f32x4 a4[4];
#pragma unroll
                for (int j = 0; j < 4; ++j) a4[j] = (f32x4){0.f, 0.f, 0.f, 0.f};
                for (int z = 0; z < npart; ++z) { const float* pr = part + ((size_t)(z * MC + (r - ML)) * DM);
#pragma unroll
                    for (int j = 0; j < 4; ++j) a4[j] += *(const f32x4*)(pr + (64 * j + lane) * 4); }
#pragma unroll
                for (int j = 0; j < 4; ++j) { v[q][j] += a4[j] * *(const f32x4*)(pgate + (64 * j + lane) * 4); *(f32x4*)(XCw + (size_t)(r - ML) * DM + (64 * j + lane) * 4) = v[q][j]; }
            }
            const float* mp = mod + mod_row(r) * 6144;
            const int nn_ = r & 4095, ro_ = perm ? (r & ~4095) + (nn_ & 31) * 128 + ((nn_ >> 5) & 1) * 64 + (nn_ >> 6) : r;
            float s = 0.f;
#pragma unroll
            for (int j = 0; j < 4; ++j) s += (v[q][j].x * v[q][j].x + v[q][j].y * v[q][j].y) + (v[q][j].z * v[q][j].z + v[q][j].w * v[q][j].w);
            const float rstd = rsqrtf(wave_sum(s) * (1.f / DM) + NORM_EPS);
#pragma unroll
            for (int j = 0; j < 4; ++j) { const int e = (64 * j + lane) * 4;
                const f32x4 gg = *(const f32x4*)(g + e), sc = *(const f32x4*)(mp + sc_off + e), sh = *(const f32x4*)(mp + sh_off + e);
                const f32x4 o = (v[q][j] * rstd) * gg * (sc + 1.0f) + sh;
                u32x2 w; w.x = cvt_pk_bf16(o[0], o[1]); w.y = cvt_pk_bf16(o[2], o[3]); *(u32x2*)(H + (size_t)ro_ * DM + e) = w; }
        }
    }
}
__device__ __forceinline__ void final_norm_phase(float* x, const float* g, int gw, int NGW, int lane) {
    constexpr int NR = 2;
    for (int r0 = gw; r0 < ML; r0 += NR * NGW) {
        f32x4 v[NR][4];
#pragma unroll
        for (int q = 0; q < NR; ++q) { const int rq = r0 + q * NGW; const float* xr = x + (size_t)(rq < ML ? rq : r0) * DM;
#pragma unroll
            for (int j = 0; j < 4; ++j) v[q][j] = *(const f32x4*)(xr + (64 * j + lane) * 4); }
#pragma unroll
        for (int q = 0; q < NR; ++q) {
            const int r = r0 + q * NGW; if (r >= ML) break;
            float* xr = x + (size_t)r * DM; float s = 0.f;
#pragma unroll
            for (int j = 0; j < 4; ++j) s += (v[q][j].x * v[q][j].x + v[q][j].y * v[q][j].y) + (v[q][j].z * v[q][j].z + v[q][j].w * v[q][j].w);
            const float rstd = rsqrtf(wave_sum(s) * (1.f / DM) + NORM_EPS);
#pragma unroll
            for (int j = 0; j < 4; ++j) { const int e = (64 * j + lane) * 4; *(f32x4*)(xr + e) = (v[q][j] * rstd) * *(const f32x4*)(g + e); }
        }
    }
}
#define UNPACK8(V_, f) do { f[0] = bf_lo(V_[0]); f[1] = bf_hi(V_[0]); f[2] = bf_lo(V_[1]); f[3] = bf_hi(V_[1]); f[4] = bf_lo(V_[2]); f[5] = bf_hi(V_[2]); f[6] = bf_lo(V_[3]); f[7] = bf_hi(V_[3]); } while (0)
__device__ __forceinline__ void conv_phase(const bf16_t* Bg, const bf16_t* U, const float* cw, bf16_t* ZG, int gw, int NGW, int lane) {
    for (int r0 = gw; r0 < MT; r0 += 2 * NGW) {
        u32x4 bgw[2][2], u0w[2][2], umw[2][2], upw[2][2];
        unsigned zu_ = 0u; asm volatile("" : "+v"(zu_)); const u32x4 zero = {zu_, zu_, zu_, zu_};
#pragma unroll
        for (int q = 0; q < 2; ++q) { const int rq = r0 + q * NGW; const int r = rq < MT ? rq : r0;
            int s, last; if (r < ML) { s = r & 4095; last = 4095; } else { s = (r - ML) & 255; last = 255; }
            const bool hasp = s > 0, hasn = s < last;
#pragma unroll
            for (int half = 0; half < 2; ++half) { const size_t o = (size_t)r * DM + (half * 64 + lane) * 8;
                bgw[q][half] = *(const u32x4*)(Bg + o); u0w[q][half] = *(const u32x4*)(U + o);
                umw[q][half] = hasp ? *(const u32x4*)(U + o - DM) : zero; upw[q][half] = hasn ? *(const u32x4*)(U + o + DM) : zero; } }
#pragma unroll
        for (int q = 0; q < 2; ++q) { const int r = r0 + q * NGW; if (r >= MT) break;
#pragma unroll
            for (int half = 0; half < 2; ++half) {
                const int e = (half * 64 + lane) * 8; const size_t o = (size_t)r * DM + e;
                float bg[8], u0[8], um[8], up[8], z[8]; UNPACK8(bgw[q][half], bg); UNPACK8(u0w[q][half], u0); UNPACK8(umw[q][half], um); UNPACK8(upw[q][half], up);
#pragma unroll
                for (int k4 = 0; k4 < 2; ++k4) { const f32x4 w0 = *(const f32x4*)(cw + e + 4 * k4), w1 = *(const f32x4*)(cw + DM + e + 4 * k4), w2 = *(const f32x4*)(cw + 2 * DM + e + 4 * k4);
#pragma unroll
                    for (int k = 0; k < 4; ++k) z[4 * k4 + k] = bg[4 * k4 + k] * (w0[k] * um[4 * k4 + k] + w1[k] * u0[4 * k4 + k] + w2[k] * up[4 * k4 + k]); }
                u32x4 w; w.x = cvt_pk_bf16(z[0], z[1]); w.y = cvt_pk_bf16(z[2], z[3]); w.z = cvt_pk_bf16(z[4], z[5]); w.w = cvt_pk_bf16(z[6], z[7]);
                *(u32x4*)(ZG + o) = w;
            }
        }
    }
}
__device__ __forceinline__ void mla_thin_phase(const bf16_t* CQ, const float* qg, const float* kvg, const float* cosT, const float* sinT, bf16_t* cqn, bf16_t* ckvn, bf16_t* Kr, int gw, int NGW, int lane) {
    constexpr int NR = 4;
    const f32x4 g1 = *(const f32x4*)(qg + 4 * lane), g2 = *(const f32x4*)(kvg + 4 * lane);
    for (int r0 = gw; r0 < MT; r0 += NR * NGW) {
        u32x2 av[NR], bv[NR]; unsigned short k1[NR], k2[NR];
#pragma unroll
        for (int q = 0; q < NR; ++q) { const int rq = r0 + q * NGW; const bf16_t* row = CQ + (size_t)(rq < MT ? rq : r0) * 768;
            av[q] = *(const u32x2*)(row + 4 * lane); bv[q] = *(const u32x2*)(row + 256 + 4 * lane); k1[q] = row[512 + (lane & 15)]; k2[q] = row[528 + (lane & 15)]; }
#pragma unroll
        for (int q = 0; q < NR; ++q) {
            const int r = r0 + q * NGW; if (r >= MT) break;
            const u32x2 a = av[q], b = bv[q];
            const float a0 = bf_lo(a.x), a1 = bf_hi(a.x), a2 = bf_lo(a.y), a3 = bf_hi(a.y), b0 = bf_lo(b.x), b1 = bf_hi(b.x), b2 = bf_lo(b.y), b3 = bf_hi(b.y);
            const float ra = rsqrtf(wave_sum(a0 * a0 + a1 * a1 + a2 * a2 + a3 * a3) * (1.f / 256.f) + NORM_EPS);
            const float rb = rsqrtf(wave_sum(b0 * b0 + b1 * b1 + b2 * b2 + b3 * b3) * (1.f / 256.f) + NORM_EPS);
            u32x2 w; w.x = cvt_pk_bf16(a0 * ra * g1[0], a1 * ra * g1[1]); w.y = cvt_pk_bf16(a2 * ra * g1[2], a3 * ra * g1[3]); *(u32x2*)(cqn + (size_t)r * 256 + 4 * lane) = w;
            w.x = cvt_pk_bf16(b0 * rb * g2[0], b1 * rb * g2[1]); w.y = cvt_pk_bf16(b2 * rb * g2[2], b3 * rb * g2[3]); *(u32x2*)(ckvn + (size_t)r * 256 + 4 * lane) = w;
            if (lane < 16) {
                const float x1 = __uint_as_float((unsigned)k1[q] << 16), x2 = __uint_as_float((unsigned)k2[q] << 16);
                float o1 = x1, o2 = x2;
                if (r < ML) { const int pos = r & 4095; const float cs = cosT[pos * 16 + lane], sn = sinT[pos * 16 + lane]; o1 = x1 * cs - x2 * sn; o2 = x1 * sn + x2 * cs; }
                Kr[(size_t)r * 32 + lane] = (bf16_t)f2bf(o1); Kr[(size_t)r * 32 + 16 + lane] = (bf16_t)f2bf(o2);
            }
        }
    }
}

__device__ __forceinline__ void shw_phase(const float* MOD, const unsigned char* ws, float* SHW, int gw, int NGW, int lane) {
    for (int it = gw; it < 4 * 2 * FH; it += NGW) {
        const int L = it / (2 * FH), n = it % (2 * FH);
        const bf16_t* wrow = (const bf16_t*)(ws + WS_FFN_IN + L * FFN_IN_STRIDE) + (size_t)n * DM;
        const u32x4 w0 = *(const u32x4*)(wrow + 8 * lane), w1 = *(const u32x4*)(wrow + 512 + 8 * lane);
        float wf[16]; UNPACK8(w0, wf); { float* wf8 = wf + 8; UNPACK8(w1, wf8); }
#pragma unroll
        for (int mr = 0; mr < 5; ++mr) {
            const float* sh = MOD + (L * 5 + mr) * 6144 + 3072;
            float acc = 0.f;
#pragma unroll
            for (int q = 0; q < 2; ++q) { const f32x4 s0 = *(const f32x4*)(sh + 512 * q + 8 * lane), s1 = *(const f32x4*)(sh + 512 * q + 8 * lane + 4);
                acc += (s0[0] * wf[8 * q] + s0[1] * wf[8 * q + 1]) + (s0[2] * wf[8 * q + 2] + s0[3] * wf[8 * q + 3]) + (s1[0] * wf[8 * q + 4] + s1[1] * wf[8 * q + 5]) + (s1[2] * wf[8 * q + 6] + s1[3] * wf[8 * q + 7]); }
            acc = wave_sum(acc);
            if (lane == 0) SHW[(size_t)(L * 6 + mr) * (2 * FH) + n] = acc;
        }
        if (lane == 0) SHW[(size_t)(L * 6 + 5) * (2 * FH) + n] = 0.f;
    }
}

template <int MODE>
__device__ __forceinline__ void attn_tile(const LAS unsigned char* bufp, LAS unsigned char* lds, const bf16x8 (&qf)[MODE == 0 ? 6 : 4], f32x16 (&o)[2], f32x16& negm, float& m_ref, float& lsum, bool& started,
                                          bool band, int rr, int qrow, int qc, int c0, int prow, int l32, int hi) {
    constexpr int DQ = MODE == 0 ? 96 : 64, NKS = DQ / 16, KP = DQ * 2 + 16, VP = 144, KBYTES = 64 * KP;
    constexpr int BIAS_OFF = 98304;
            const LAS unsigned char* kp = bufp;
            const LAS unsigned char* vp = kp + KBYTES;
            f32x16 s[2];
            bf16x8 kf[NKS][2];
#pragma unroll
            for (int ks = 0; ks < NKS; ++ks)
#pragma unroll
                for (int kh = 0; kh < 2; ++kh) kf[ks][kh] = *(const LAS bf16x8*)(kp + (32 * kh + prow) * KP + (16 * ks + 8 * hi) * 2);
            __builtin_amdgcn_sched_barrier(0);
            __builtin_amdgcn_s_setprio(1);
#pragma unroll
            for (int ks = 0; ks < NKS; ++ks)
#pragma unroll
                for (int kh = 0; kh < 2; ++kh) s[kh] = __builtin_amdgcn_mfma_f32_32x32x16_bf16(kf[ks][kh], qf[ks], ks == 0 ? negm : s[kh], 0, 0, 0);
            __builtin_amdgcn_s_setprio(0);
            if (MODE == 1 && band) {
                const LAS float* bl = (const LAS float*)(lds + BIAS_OFF) + (rr - qrow + 7) * 128 + (63 - qc + 8 * hi);
#pragma unroll
                for (int kh = 0; kh < 2; ++kh)
#pragma unroll
                    for (int i = 0; i < 16; ++i) { const int kcl = 32 * kh + 16 * (i >> 3) + (i & 7); const int kc = kcl + 8 * hi;
                        const bool valid = (unsigned)(kc - c0) < 16u; s[kh][i] = valid ? s[kh][i] + bl[kcl] : -1.0e30f; }
            }
            float mx = fmaxf(s[0][0], s[1][0]);
#pragma unroll
            for (int i = 1; i < 16; ++i) mx = fmaxf(fmaxf(mx, s[0][i]), s[1][i]);
            mx = xor32_max(mx);
            const float delta = (!started || mx > 8.0f) ? mx : 0.f;
            if (__builtin_amdgcn_ballot_w64(delta != 0.f) != 0ull) {
                const float alpha = started ? __builtin_amdgcn_exp2f(-delta) : 1.0f;
                lsum *= alpha; m_ref += delta;
#pragma unroll
                for (int i = 0; i < 16; ++i) negm[i] = -m_ref;
#pragma unroll
                for (int i = 0; i < 16; ++i) { o[0][i] *= alpha; o[1][i] *= alpha; s[0][i] -= delta; s[1][i] -= delta; }
            }
            started = true;
            bf16x8 vf[2][2][2];
#pragma unroll
            for (int kh = 0; kh < 2; ++kh)
#pragma unroll
                for (int t = 0; t < 2; ++t)
#pragma unroll
                    for (int dh = 0; dh < 2; ++dh) vf[kh][t][dh] = *(const LAS bf16x8*)(vp + (32 * dh + l32) * VP + (32 * kh + 16 * t + 8 * hi) * 2);
            __builtin_amdgcn_sched_barrier(0);
            float ps = 0.f;
#pragma unroll
            for (int kh = 0; kh < 2; ++kh)
#pragma unroll
                for (int i = 0; i < 16; ++i) { const float pv = __builtin_amdgcn_exp2f(s[kh][i]); s[kh][i] = pv; ps += pv; }
            lsum += ps;
            bf16x8 pf[2][2];
#pragma unroll
            for (int kh = 0; kh < 2; ++kh)
#pragma unroll
                for (int t = 0; t < 2; ++t) { u32x4 w; w.x = cvt_pk_bf16(s[kh][8 * t + 0], s[kh][8 * t + 1]); w.y = cvt_pk_bf16(s[kh][8 * t + 2], s[kh][8 * t + 3]);
                    w.z = cvt_pk_bf16(s[kh][8 * t + 4], s[kh][8 * t + 5]); w.w = cvt_pk_bf16(s[kh][8 * t + 6], s[kh][8 * t + 7]); pf[kh][t] = __builtin_bit_cast(bf16x8, w); }
#pragma unroll
            for (int kh = 0; kh < 2; ++kh)
#pragma unroll
                for (int t = 0; t < 2; ++t)
#pragma unroll
                    for (int dh = 0; dh < 2; ++dh) { __builtin_amdgcn_s_setprio(1); o[dh] = __builtin_amdgcn_mfma_f32_32x32x16_bf16(vf[kh][t][dh], pf[kh][t], o[dh], 0, 0, 0); __builtin_amdgcn_s_setprio(0); }
}
template <int MODE>
__device__ __forceinline__ void attn_unit(LAS unsigned char* lds, int b, int h, int uq, const bf16_t* Qn, const bf16_t* Qr, const bf16_t* Kn, const bf16_t* Kr, const bf16_t* Vt,
                                          bf16_t* O, const float* rpb_h, const float* cosT, const float* sinT, float qscale, int tid, int wid, int lane) {
    constexpr int DQ = MODE == 0 ? 96 : 64, NKS = DQ / 16, KP = DQ * 2 + 16, VP = 144, KBYTES = 64 * KP, BUFB = KBYTES + 64 * VP;
    constexpr int BIAS_OFF = 98304;
    const int l32 = lane & 31, hi = lane >> 5;
    int q0, T, nb = 0, R0 = 0, qrow = 0, r0w = 0, qc = 0, c0 = 0;
    if (MODE == 0) { q0 = b * SEQ + uq * 256 + wid * 32; T = NKEY / 64; }
    else if (MODE == 1) { qrow = 4 * uq + (wid >> 1); q0 = b * SEQ + qrow * 64 + 32 * (wid & 1);
        R0 = min(max(4 * uq - 4, 0), 56); const int lastr = min(max(4 * uq - 1, 0), 56) + 7; nb = lastr - R0 + 1; T = nb + 4;
        r0w = min(max(qrow - 4, 0), 56); qc = 32 * (wid & 1) + l32; c0 = min(max(qc - 8, 0), 48); }
    else { q0 = ML + b * CTXL + wid * 32; T = 4; }
    bf16x8 qf[NKS];
#pragma unroll
    for (int ks = 0; ks < 4; ++ks) qf[ks] = *(const bf16x8*)(Qn + (size_t)(q0 + l32) * 1024 + h * 64 + 16 * ks + 8 * hi);
    if (MODE == 0) {
        const u32x4 r1 = *(const u32x4*)(Qr + (size_t)(q0 + l32) * 512 + h * 32 + 8 * hi), r2 = *(const u32x4*)(Qr + (size_t)(q0 + l32) * 512 + h * 32 + 16 + 8 * hi);
        const int pos = (q0 + l32) & 4095;
        const f32x4 ca = *(const f32x4*)(cosT + pos * 16 + 8 * hi), cb = *(const f32x4*)(cosT + pos * 16 + 8 * hi + 4);
        const f32x4 sa = *(const f32x4*)(sinT + pos * 16 + 8 * hi), sb = *(const f32x4*)(sinT + pos * 16 + 8 * hi + 4);
        u32x4 w1, w2;
#pragma unroll
        for (int i = 0; i < 4; ++i) {
            const float x1l = bf_lo(r1[i]), x1h = bf_hi(r1[i]), x2l = bf_lo(r2[i]), x2h = bf_hi(r2[i]);
            const float cl = i < 2 ? ca[2 * i] : cb[2 * i - 4], ch = i < 2 ? ca[2 * i + 1] : cb[2 * i - 3];
            const float sl = i < 2 ? sa[2 * i] : sb[2 * i - 4], sh = i < 2 ? sa[2 * i + 1] : sb[2 * i - 3];
            w1[i] = cvt_pk_bf16((x1l * cl - x2l * sl) * qscale, (x1h * ch - x2h * sh) * qscale);
            w2[i] = cvt_pk_bf16((x1l * sl + x2l * cl) * qscale, (x1h * sh + x2h * ch) * qscale);
        }
        qf[4] = __builtin_bit_cast(bf16x8, w1); qf[5] = __builtin_bit_cast(bf16x8, w2);
    }
    if (MODE == 1) { LAS float* bl = (LAS float*)(lds + BIAS_OFF);
        for (int idx = tid; idx < 15 * 128; idx += 512) { const int ro = idx >> 7, cc = idx & 127; bl[idx] = (cc >= 48 && cc < 79) ? rpb_h[ro * 31 + cc - 48] * LOG2E : 0.f; } }
    const int skey = tid >> 3, sch = tid & 7;
    const bf16_t* vbase = Vt + (size_t)(b * DM + h * 64 + skey) * NKEY + sch * 8;
    u32x4 kreg0, rreg0, vreg0, kreg1, rreg1, vreg1;
    rreg0.x = 0u; asm volatile("" : "+v"(rreg0.x)); rreg0.y = rreg0.x; rreg0.z = rreg0.x; rreg0.w = rreg0.x; rreg1 = rreg0;
#define TILE_KB(j) (MODE == 0 ? 64 * (j) : (MODE == 1 ? ((j) < nb ? (R0 + (j)) * 64 : SEQ + ((j) - nb) * 64) : SEQ + 64 * (j)))
#define GLD16(dst, ptr) asm volatile("global_load_dwordx4 %0, %1, off" : "=&v"(dst) : "v"(ptr) : "memory")
#define WAIT_VM0() asm volatile("s_waitcnt vmcnt(0)" ::: "memory")
#define GLOAD(j, S) do { if ((j) < T) { const int kb_ = TILE_KB(j), tk_ = key_tok(b, kb_); \
        GLD16(kreg##S, Kn + (size_t)(tk_ + skey) * 1024 + h * 64 + sch * 8); \
        if (MODE == 0) GLD16(rreg##S, Kr + (size_t)(tk_ + ((tid & 255) >> 2)) * 32 + (tid & 3) * 8); \
        GLD16(vreg##S, vbase + kb_); } } while (0)
#define LSTORE(j, S) do { if ((j) < T) { LAS unsigned char* bp_ = lds + ((((j) >> 1) & 1) * 2 + ((j) & 1)) * BUFB; \
        *(LAS u32x4*)(bp_ + skey * KP + sch * 16) = kreg##S; \
        if (MODE == 0) { if (tid < 256) *(LAS u32x4*)(bp_ + (tid >> 2) * KP + 128 + (tid & 3) * 16) = rreg##S; } \
        *(LAS u32x4*)(bp_ + KBYTES + skey * VP + sch * 16) = vreg##S; } } while (0)
#define BAR_LDS() do { asm volatile("s_waitcnt lgkmcnt(0)" ::: "memory"); __builtin_amdgcn_s_barrier(); asm volatile("" ::: "memory"); } while (0)
    GLOAD(0, 0); GLOAD(1, 1); WAIT_VM0(); LSTORE(0, 0); LSTORE(1, 1); GLOAD(2, 0); GLOAD(3, 1);
    BAR_LDS();
    f32x16 o[2];
#pragma unroll
    for (int i = 0; i < 16; ++i) { o[0][i] = 0.f; o[1][i] = 0.f; }
    float m_ref = 0.f, lsum = 0.f; bool started = false;
    f32x16 negm;
#pragma unroll
    for (int i = 0; i < 16; ++i) negm[i] = 0.f;
    const int prow = (l32 & ~12) | ((l32 & 4) << 1) | ((l32 & 8) >> 1);
#define ATT_TILE(j) do { if ((j) < T) { \
        bool band_ = false, active_ = true; int rr_ = 0; \
        if (MODE == 1 && (j) < nb) { band_ = true; rr_ = R0 + (j); active_ = (rr_ >= r0w) && (rr_ < r0w + 8); } \
        if (active_) attn_tile<MODE>(lds + ((((j) >> 1) & 1) * 2 + ((j) & 1)) * BUFB, lds, qf, o, negm, m_ref, lsum, started, band_, rr_, qrow, qc, c0, prow, l32, hi); } } while (0)
    for (int j = 0; j < T; j += 2) {
        ATT_TILE(j); ATT_TILE(j + 1);
        WAIT_VM0(); LSTORE(j + 2, 0); LSTORE(j + 3, 1);
        GLOAD(j + 4, 0); GLOAD(j + 5, 1);
        BAR_LDS();
    }
#undef ATT_TILE
#undef TILE_KB
#undef GLOAD
#undef LSTORE
#undef GLD16
#undef WAIT_VM0
#undef BAR_LDS
    const float ltot = xor32_sum(lsum), inv = 1.0f / ltot;
    bf16_t* orow = O + (size_t)(q0 + l32) * 1024 + h * 64 + 4 * hi;
#pragma unroll
    for (int dh = 0; dh < 2; ++dh)
#pragma unroll
        for (int g4 = 0; g4 < 4; ++g4) { u32x2 w; w.x = cvt_pk_bf16(o[dh][4 * g4] * inv, o[dh][4 * g4 + 1] * inv); w.y = cvt_pk_bf16(o[dh][4 * g4 + 2] * inv, o[dh][4 * g4 + 3] * inv);
            *(u32x2*)(orow + 32 * dh + 8 * g4) = w; }
}

#define XB_TMO      128
#define XB_XCNT(j)  (256  + 64 * (j))
#define XB_XSUB(j)  (1280 + 64 * (j))
#define XB_XGEN(j)  (2304 + 64 * (j))
#define XB_TOP      3328
#define XB_TOPGEN   3392
#define XCD_BAR_WORDS 3456
#define XB_SPIN_CAP (1u << 18)

__device__ __forceinline__ unsigned xb_ld(unsigned* p)              { return __hip_atomic_load(p, __ATOMIC_RELAXED, __HIP_MEMORY_SCOPE_AGENT); }
__device__ __forceinline__ unsigned xb_add(unsigned* p, unsigned v) { return __hip_atomic_fetch_add(p, v, __ATOMIC_RELAXED, __HIP_MEMORY_SCOPE_AGENT); }
__device__ __forceinline__ unsigned xb_xcc_id() { return (unsigned)__builtin_amdgcn_s_getreg((3 << 11) | 20) & 0xFu; }
#define XB_SPIN(cond, bar) do { unsigned _sp = 0; while (cond) { __builtin_amdgcn_s_sleep(1); \
    if ((++_sp & 255u) == 0u) { if (xb_ld(&(bar)[XB_TMO])) break; if (_sp > XB_SPIN_CAP) { atomicAdd(&(bar)[XB_TMO], 1u); break; } } } } while (0)

struct XcdBarrier {
    unsigned* bar; unsigned x;
    volatile LAS unsigned* st;
};

__device__ __forceinline__ XcdBarrier xcd_barrier_post(unsigned* bar, volatile LAS unsigned* st) {
    XcdBarrier b; b.bar = bar; b.x = xb_xcc_id(); b.st = st;
    if (threadIdx.x == 0) (void)xb_add(&bar[XB_XCNT(b.x)], 1u);
    return b;
}
__device__ __forceinline__ void xcd_barrier_complete(unsigned* bar, unsigned x, unsigned& nloc, unsigned& nx) {
    const unsigned G = gridDim.x * gridDim.y * gridDim.z;
    unsigned sum, cnt, mine, sp = 0u;
    for (;;) {
        sum = 0u; cnt = 0u; mine = 0u;
#pragma unroll
        for (unsigned j = 0; j < 16; ++j) { const unsigned c = xb_ld(&bar[XB_XCNT(j)]); sum += c; cnt += (c > 0u) ? 1u : 0u; mine = (j == x) ? c : mine; }
        if (sum == G) break;
        __builtin_amdgcn_s_sleep(1);
        if ((++sp & 255u) == 0u) { if (xb_ld(&bar[XB_TMO])) break; if (sp > XB_SPIN_CAP) { atomicAdd(&bar[XB_TMO], 1u); break; } }
    }
    nloc = mine > 0u ? mine : 1u; nx = cnt > 0u ? cnt : 1u;
}

__device__ __forceinline__ void xcd_barrier(const XcdBarrier& b) {
    asm volatile("s_waitcnt vmcnt(0)" ::: "memory");
    __syncthreads();
    if (threadIdx.x == 0) {
        unsigned* bar = b.bar;
        __builtin_amdgcn_s_waitcnt(0);
        unsigned nloc = b.st[0], nx = b.st[1];
        if (nloc == 0u) { xcd_barrier_complete(bar, b.x, nloc, nx); b.st[0] = nloc; b.st[1] = nx; }
        const unsigned old = xb_add(&bar[XB_XSUB(b.x)], 1u);
        const unsigned gen = old / nloc;
        if (old + 1u == (gen + 1u) * nloc) {
            __builtin_amdgcn_fence(__ATOMIC_RELEASE, "agent");
            asm volatile("s_waitcnt vmcnt(0)" ::: "memory");
            const unsigned og = xb_add(&bar[XB_TOP], 1u);
            const unsigned tg = og / nx;
            if (og + 1u == (tg + 1u) * nx) xb_add(&bar[XB_TOPGEN], 1u);
            else XB_SPIN(xb_ld(&bar[XB_TOPGEN]) == tg, bar);
            __builtin_amdgcn_fence(__ATOMIC_ACQUIRE, "agent");
            xb_add(&bar[XB_XGEN(b.x)], 1u);
            asm volatile("s_waitcnt vmcnt(0)" ::: "memory");
        } else {
            XB_SPIN(xb_ld(&bar[XB_XGEN(b.x)]) == gen, bar);
            __builtin_amdgcn_fence(__ATOMIC_ACQUIRE, "agent");
            asm volatile("s_waitcnt vmcnt(0)" ::: "memory");
        }
    }
    __syncthreads();
}

#ifndef FUSE_FFN_NORM
#define FUSE_FFN_NORM 0
#endif
constexpr int NPHASES = 38;
constexpr int LDS_BYTES = 147456, MISC_OFF = 131072 + 320;
constexpr size_t WS_CTL = 512 * 1024, CTL_BYTES = 16384;
__host__ __device__ __forceinline__ bool phase_empty(int ph) {
    if (ph == 0 || ph == NPHASES - 1) return false;
    const int L = (ph - 1) / 9, lp = (ph - 1) % 9;
    if (lp == 2) return !(L == 0 || L == 2);
    if (lp == 3) return !(L == 2 || L == 3);
    if (lp == 4) return L == 0;
    if (lp == 6) return FUSE_FFN_NORM && L >= 2;
    return false;
}

#ifndef PROBE_PH
#define PROBE_PH (-1)
#define PROBE_REPS 1
#endif
#ifndef PROBE_BAR_ONLY
#define PROBE_BAR_ONLY 0
#endif
template <bool COOP>
__global__ void __launch_bounds__(512, 2) fwd_kernel(Params p) {
    extern __shared__ __attribute__((aligned(16))) unsigned char lds_raw[];
    LAS unsigned char* lds = (LAS unsigned char*)lds_raw;
    const int tid0 = threadIdx.x;
    volatile LAS unsigned* MISC = (volatile LAS unsigned*)(lds + MISC_OFF);
    if (tid0 < 32) MISC[tid0] = 0u;
    __syncthreads();
    XcdBarrier bar; bar.bar = nullptr; bar.x = 0; bar.st = nullptr;
    if (COOP) bar = xcd_barrier_post((unsigned*)(p.ws + WS_CTL), MISC + 8);

    for (int ph = p.ph_lo; ph < p.ph_hi; ++ph) {
        if (phase_empty(ph)) continue;
        for (int rep = 0; rep < ((ph == PROBE_PH) ? PROBE_REPS : 1); ++rep) {
        if (rep > 0) { if (COOP) xcd_barrier(bar); if (PROBE_BAR_ONLY) continue; }
        int tid = tid0; asm volatile("" : "+v"(tid));
        size_t wsoff = 0; asm volatile("" : "+s"(wsoff)); unsigned char* ws = p.ws + wsoff;
        int G = gridDim.x, bid = blockIdx.x; asm volatile("" : "+s"(G), "+s"(bid));
        const int vcu = (G % 8 == 0) ? (bid % 8) * (G / 8) + bid / 8 : bid;
        const int lane = tid & 63, wid = __builtin_amdgcn_readfirstlane(tid >> 6);
        const int gw = bid * 8 + wid, NGW = G * 8;
        float* MOD = (float*)(ws + WS_MOD);
        const float* cosT = (const float*)(ws + WS_ROPE); const float* sinT = cosT + 4096 * 16;
        bf16_t* H = (bf16_t*)(ws + WS_H);
        bf16_t* BIG = (bf16_t*)(ws + WS_BIG);
        bf16_t* BIG1 = (bf16_t*)(ws + WS_BIG + SUB);
        bf16_t* BIG2 = (bf16_t*)(ws + WS_BIG + 2 * SUB);
        bf16_t* ZG = (bf16_t*)(ws + WS_ZG);
        bf16_t* CQN = ZG; bf16_t* CKVN = (bf16_t*)(ws + WS_ZG + 9 * MiB); bf16_t* QR = (bf16_t*)(ws + WS_ZG + 18 * MiB);
        bf16_t* VT = (bf16_t*)(ws + WS_VT);
        bf16_t* KR = (bf16_t*)(ws + WS_KR);
        float* XC = (float*)(ws + WS_XC);
        if (ph == 0) {
#ifndef NO_PREP
            prep_phase(p, ws, lds, G, bid, tid, wid, lane);
#endif
        }
        else if (ph == NPHASES - 1) final_norm_phase(p.out, p.in[I_FINAL_G], gw, NGW, lane);
        else {
            const int L = (ph - 1) / 9, lp = (ph - 1) % 9;
            const float* modL = MOD + L * 5 * 6144;
            const float* srcL = L == 0 ? p.in[I_X] : p.out; const float* srcC = L == 0 ? p.in[I_CTX] : XC;
            const int nMf = L < 2 ? MT / 256 : ML / 256;
            bf16_t* HN = (FUSE_FFN_NORM && (L == 1 || L == 2)) ? ZG : H;
            if (FUSE_FFN_NORM && lp == 0 && L == 0) shw_phase(MOD, ws, (float*)(ws + WS_SHW), gw, NGW, lane);
            if (lp == 0) norm_phase(srcL, srcC, L < 3 ? MT : ML, p.in[I_MIXG] + L * DM, modL, 0, 1024, H, (const float*)ZG, (L == 1 || L == 2) ? 11 : 0, modL - 5 * 6144 + 4 * 6144 + 5120, XC, L == 3, 0, gw, NGW, lane);
            else if (lp == 6) norm_phase(p.out, XC, L < 2 ? MT : ML, p.in[I_FFNG] + L * DM, modL, 3072, 4096, HN, (const float*)VT, L < 2 ? 4 : 0, modL + 4 * 6144 + 2048, XC, 0, FUSE_FFN_NORM ? ML : 0, gw, NGW, lane);
            else if (lp == 2) {
                if (L == 0) conv_phase(BIG, BIG1, p.in[I_CONV_W], ZG, gw, NGW, lane);
                else mla_thin_phase(BIG2, p.in[I_MLA_QG], p.in[I_MLA_KVG], cosT, sinT, CQN, CKVN, KR, gw, NGW, lane);
            } else if (lp == 4 && L != 3) {
#ifndef NO_ATT
                if (L == 1) {
                    for (int u = vcu; u < 1024 + 64; u += G) {
                        if (u < 1024) { const int bh = u >> 4; attn_unit<1>(lds, bh >> 4, bh & 15, u & 15, BIG, nullptr, BIG1, nullptr, VT, H, p.in[I_NAT_RPB] + (bh & 15) * 15 * 31, nullptr, nullptr, 1.f, tid, wid, lane); }
                        else { const int bh = u - 1024; attn_unit<2>(lds, bh >> 4, bh & 15, 0, BIG, nullptr, BIG1, nullptr, VT, H, nullptr, nullptr, nullptr, 1.f, tid, wid, lane); }
                    }
                } else {
                    for (int u = vcu; u < 1024; u += G) { const int bh = u >> 4; attn_unit<0>(lds, bh >> 4, bh & 15, u & 15, BIG, QR, BIG1, KR, VT, H, nullptr, cosT, sinT, 0.10206207261596575f * LOG2E, tid, wid, lane); }
                }
#endif
            } else if (lp == 5 || lp == 8) {
                for (int job = 0; job < (L < 2 ? 2 : 1); ++job) {
                    pg8::Gemm g; pg8::ResidEpi E; pg8::Order S;
                    E.dstL = p.out; E.dstC = XC; E.srcC = XC; E.rbase = job ? ML : 0; E.atomic = job; E.part = (float*)(lp == 5 ? VT : ZG);
                    E.fuse = FUSE_FFN_NORM && (lp == 5 && job == 0); E.Hn = HN; E.g2 = p.in[I_FFNG] + L * DM; E.sc2 = modL + 4096; E.rowss = (float*)(ws + WS_ROWSS) + L * ML;
                    if (lp == 5) {
                        g.A = ((L == 0 || L == 3) ? ZG : H) + (job ? (size_t)ML * 1024 : 0); g.lda = 1024; g.ldb = 1024; g.K = job ? 256 : 1024;
                        g.Bt = (const bf16_t*)(ws + (L == 0 ? WS_CONV_OUT : L == 1 ? WS_NAT_O : L == 2 ? WS_MLA_O : WS_FNET_O));
                        E.srcL = srcL; E.gate = modL + 2048;
                        if (job) S.init(4, 4, 4, G, bid); else S.init(ML / 256, 4, 1, G, bid);
                    } else {
                        g.A = BIG + (job ? (size_t)ML * FH : 0); g.lda = FH; g.ldb = FH; g.K = job ? 256 : FH; g.Bt = (const bf16_t*)(ws + WS_FFN_OUT + L * FFN_OUT_STRIDE);
                        E.srcL = p.out; E.gate = modL + 5120;
                        if (job) S.init(4, 4, 11, G, bid); else S.init(ML / 256, 4, 1, G, bid);
                    }
                    g.zsA = job ? 512 : 0; g.zsB = job ? 512 : 0;
#ifndef NO_RESID
                    pg8::gemm_phase<pg8::ResidEpi, pg8::Order, true, true>(lds, g, S, E, tid);
#endif
                }
            } else if (lp == 7 || (lp == 1 && L == 0)) {
                pg8::Gemm g; pg8::PairEpi E; pg8::Order S;
                g.A = (lp == 7) ? HN : H; g.lda = 1024; g.ldb = 1024; g.K = 1024; g.zsA = 0; g.zsB = 0;
                E.fuse = FUSE_FFN_NORM && (lp == 7); E.rowss = (const float*)(ws + WS_ROWSS) + L * ML; E.shw = (const float*)(ws + WS_SHW) + (size_t)L * 6 * (2 * FH);
                if (lp == 7) { g.Bt = (const bf16_t*)(ws + WS_FFN_IN + L * FFN_IN_STRIDE); E.act = 1; E.pn0 = 0; E.O0 = BIG; E.ld0 = FH; E.O1 = BIG; E.ld1 = FH; S.init(nMf, 22, 1, G, bid); }
                else { g.Bt = (const bf16_t*)(ws + WS_CONV_IN); E.act = 0; E.pn0 = 4; E.O0 = BIG; E.ld0 = 1024; E.O1 = BIG1; E.ld1 = 1024; S.init(MT / 256, 12, 1, G, bid); }
                #ifndef NO_PAIR
                pg8::gemm_phase<pg8::PairEpi, pg8::Order, true, true>(lds, g, S, E, tid);
#endif
            } else {
                const int njobs = (lp == 1) ? (L == 1 ? 3 : 1) : (L == 2 ? 4 : 1);
                for (int job = 0; job < njobs; ++job) {
                    pg8::Gemm g; pg8::StoreEpi E; pg8::Order S;
                    g.zsA = 0; g.zsB = 0; E.mode = 0; E.s0 = 1.f; E.O1 = nullptr; E.ld1 = 0; E.zrows = 0; E.split = 1 << 30; E.ld0 = 1024; E.coff = 0;
                    if (lp == 1 && L == 1) {
                        g.lda = 1024; g.ldb = 1024; g.K = 1024;
                        const bool cx = job == 2;
                        const bool vjob = job == 1 || (cx && bid >= 32);
                        const size_t ro = cx ? (size_t)ML * 1024 : 0;
                        if (!vjob) { g.A = H + ro; g.Bt = (const bf16_t*)(ws + WS_NAT_QK); E.O0 = BIG + ro; E.s0 = 0.125f * LOG2E; E.split = 1024; E.O1 = BIG1 + ro; E.ld1 = 1024;
                            if (cx) S.init(4, 8, 1, 32, bid); else S.init(ML / 256, 8, 1, G, bid); }
                        else { g.A = (const bf16_t*)(ws + WS_NAT_V); g.Bt = H + ro; E.mode = 1; E.O0 = VT; E.coff = cx ? ML : 0;
                            if (cx) S.init(bid < 48 ? 4 : 0, 4, 1, 16, bid - 32); else S.init(4, ML / 256, 1, G, bid); }
                    }
                    else if (lp == 1 && L == 2) { g.A = H; g.Bt = (const bf16_t*)(ws + WS_MLA_A); g.lda = 1024; g.ldb = 1024; g.K = 1024; E.O0 = BIG2; E.ld0 = 768; S.init(MT / 256, 3, 1, G, bid); }
                    else if (lp == 1) { g.A = (const bf16_t*)(ws + WS_DFTA); g.Bt = H; g.lda = 256; g.ldb = 1024; g.K = 256; g.zsB = 512; E.mode = 2; E.O0 = BIG; S.init(2, ML / 256, 4, G, bid); }
                    else if (L == 2 && (job == 0 || (job == 3 && bid < 144))) { const bool cx = job == 3; const size_t ro = cx ? (size_t)ML : 0;
                        g.A = CKVN + ro * 256; g.Bt = (const bf16_t*)(ws + WS_MLA_K); g.lda = 256; g.ldb = 256; g.K = 256; E.O0 = BIG1 + ro * 1024;
                        if (cx) S.init(bid >= 128 ? 4 : 0, 4, 1, 16, bid - 128); else S.init(ML / 256, 4, 1, G, bid); }
                    else if (L == 2 && job == 2) { g.A = CQN; g.Bt = (const bf16_t*)(ws + WS_MLA_UQ); g.lda = 256; g.ldb = 256; g.K = 256;
                        E.O0 = BIG; E.s0 = 0.10206207261596575f * LOG2E; E.split = 1024; E.O1 = QR; E.ld1 = 512; S.init(ML / 256, 6, 1, G, bid); }
                    else if (L == 2) { const bool cx = job == 3; const size_t ro = cx ? (size_t)ML : 0;
                        g.A = (const bf16_t*)(ws + WS_MLA_V); g.Bt = CKVN + ro * 256; g.lda = 256; g.ldb = 256; g.K = 256; E.mode = 1; E.O0 = VT; E.coff = cx ? ML : 0;
                        if (cx) S.init(bid < 160 ? 4 : 0, 4, 1, 16, bid - 144); else S.init(4, ML / 256, 1, G, bid); }
                    else if (lp == 3) { g.A = (const bf16_t*)(ws + WS_DFTA) + 512 * 256; g.Bt = BIG; g.lda = 256; g.ldb = 256; g.K = 256; E.mode = 3; E.O0 = (bf16_t*)(ws + WS_DFTB); S.init(1, 512, 1, G, bid); }
                    else { g.A = (const bf16_t*)(ws + WS_DFTA) + 768 * 256; g.Bt = (const bf16_t*)(ws + WS_DFTB); g.lda = 256; g.ldb = 256; g.K = 256; E.mode = 4; E.O0 = ZG; S.init(1, 512, 1, G, bid); }
                    #ifndef NO_STORE
                    pg8::gemm_phase<pg8::StoreEpi, pg8::Order, true, true>(lds, g, S, E, tid);
#endif
                }
            }
        }
        }
        if (COOP) { if (ph + 1 < p.ph_hi) { if (ph == 0) cg::this_grid().sync(); else xcd_barrier(bar); } }
    }
}

#ifndef MK_MULTI
#define MK_MULTI 0
#endif
extern "C" void kernel_launch(void* const* d_in, const int* in_sizes, int n_in, void* d_out, int out_size, void* d_ws, size_t ws_size, hipStream_t stream) {
    static int grid = 0;
    if (grid == 0) {
        if (n_in != 25 || out_size != ML * DM || ws_size < WS_END) { fprintf(stderr, "kernel_launch: unexpected problem: n_in %d out %d ws %zu (need %zu)\n", n_in, out_size, ws_size, (size_t)WS_END); grid = -1; return; }
        int dev = 0, cus = 0, per_cu = 0;
        (void)hipGetDevice(&dev); (void)hipDeviceGetAttribute(&cus, hipDeviceAttributeMultiprocessorCount, dev);
        (void)hipFuncSetAttribute((const void*)fwd_kernel<true>, hipFuncAttributeMaxDynamicSharedMemorySize, LDS_BYTES);
        (void)hipFuncSetAttribute((const void*)fwd_kernel<false>, hipFuncAttributeMaxDynamicSharedMemorySize, LDS_BYTES);
        (void)hipOccupancyMaxActiveBlocksPerMultiprocessor(&per_cu, (const void*)fwd_kernel<true>, 512, LDS_BYTES);
        if (per_cu < 1) { fprintf(stderr, "kernel_launch: occupancy query says %d blocks per CU\n", per_cu); per_cu = 1; }
        (void)hipGetLastError();
        grid = cus;
        if (grid <= 0) grid = 256;
    }
    if (grid < 0) return;
    Params p{};
    for (int i = 0; i < 25; ++i) p.in[i] = (const float*)d_in[i];
    p.out = (float*)d_out; p.ws = (unsigned char*)d_ws;
#if MK_MULTI
    for (int ph = 0; ph < NPHASES; ++ph) {
        if (phase_empty(ph)) continue;
        p.ph_lo = ph; p.ph_hi = ph + 1;
        hipLaunchKernelGGL(fwd_kernel<false>, dim3(grid), dim3(512), LDS_BYTES, stream, p);
    }
#else
    p.ph_lo = 0; p.ph_hi = NPHASES;
    (void)hipMemsetAsync((char*)d_ws + WS_CTL, 0, CTL_BYTES, stream);
    void* args[] = {&p};
    hipError_t e = hipLaunchCooperativeKernel((const void*)fwd_kernel<true>, dim3(grid), dim3(512), args, LDS_BYTES, stream);
    if (e != hipSuccess) fprintf(stderr, "cooperative launch failed: %s (grid %d)\n", hipGetErrorString(e), grid);
#endif
}
```

```cpp
#include <hip/hip_runtime.h>
#include <hip/hip_cooperative_groups.h>
#include <cstdio>
#include <cstdint>
namespace cg = cooperative_groups;

#define LAS __attribute__((address_space(3)))
typedef unsigned short bf16_t;
typedef short bf16x8 __attribute__((ext_vector_type(8)));
typedef float f32x4 __attribute__((ext_vector_type(4)));
typedef float f32x2 __attribute__((ext_vector_type(2)));
typedef float f32x16 __attribute__((ext_vector_type(16)));
typedef unsigned u32x4 __attribute__((ext_vector_type(4)));
typedef unsigned u32x2 __attribute__((ext_vector_type(2)));

__device__ __forceinline__ unsigned cvt_pk_bf16(float lo, float hi) { unsigned r; asm("v_cvt_pk_bf16_f32 %0, %1, %2" : "=v"(r) : "v"(lo), "v"(hi)); return r; }
__device__ __forceinline__ float bf_lo(unsigned w) { return __uint_as_float(w << 16); }
__device__ __forceinline__ float bf_hi(unsigned w) { return __uint_as_float(w & 0xffff0000u); }
__device__ __forceinline__ float silu_f(float v) { return v * __builtin_amdgcn_rcpf(1.0f + __expf(-v)); }
__device__ __forceinline__ float xor32_sum(float v) { const auto rr = __builtin_amdgcn_permlane32_swap(__float_as_uint(v), __float_as_uint(v), false, false); return __uint_as_float(rr[0]) + __uint_as_float(rr[1]); }
__device__ __forceinline__ float xor32_max(float v) { const auto rr = __builtin_amdgcn_permlane32_swap(__float_as_uint(v), __float_as_uint(v), false, false); return fmaxf(__uint_as_float(rr[0]), __uint_as_float(rr[1])); }
#define SWZ_XOR(v, k) __int_as_float(__builtin_amdgcn_ds_swizzle(__float_as_int(v), ((k) << 10) | 0x1f))
__device__ __forceinline__ float wave_sum(float v) {
    v += SWZ_XOR(v, 1); v += SWZ_XOR(v, 2); v += SWZ_XOR(v, 4); v += SWZ_XOR(v, 8); v += SWZ_XOR(v, 16);
    return xor32_sum(v);
}

constexpr int DM = 1024, NB = 4, SEQ = 4096, CTXL = 256, FH = 2816;
constexpr int ML = NB * SEQ;
constexpr int MC = NB * CTXL;
constexpr int MT = ML + MC;
constexpr int NKEY = SEQ + CTXL;
constexpr float LOG2E = 1.4426950408889634f;
constexpr float NORM_EPS = 1e-6f;

__device__ __forceinline__ int mod_row(int r) { return r < ML ? (r >> 12) : 4; }
__device__ __forceinline__ void tok_bk(int t, int& b, int& key) { if (t < ML) { b = t >> 12; key = t & 4095; } else { const int c = t - ML; b = c >> 8; key = SEQ + (c & 255); } }
__device__ __forceinline__ int key_tok(int b, int key) { return key < SEQ ? b * SEQ + key : ML + b * CTXL + (key - SEQ); }

namespace pg8 {
#define PG8_LAS __attribute__((address_space(3)))
constexpr int BM = 256, BK = 64, HALF = 128, HTB = HALF * BK * 2, STAGE_BYTES = 8 * HTB, NXCD = 8, WGM = 8;
__host__ __device__ __forceinline__ int lds_byte(int r, int c) { const int st = (r >> 4) * 2 + (c >> 5), rr = r & 15, cc = c & 31, ob = rr * 64 + cc * 2; return st * 1024 + (ob ^ (((ob >> 9) & 1) << 5)); }
__host__ __device__ __forceinline__ void stage_rc(int b, int& R, int& C) { const int st = b / 1024, sb = b % 1024, swz = sb ^ (((sb >> 9) & 1) << 5); R = (st >> 1) * 16 + swz / 64; C = (st & 1) * 32 + (swz % 64) / 2; }
__host__ __device__ __forceinline__ int perm32(int rho) { const int n = rho >> 4, i = rho & 15; return 8 * (i >> 2) + 4 * n + (i & 3); }

struct Unit { int pm, pn, z; };
struct Gemm { const bf16_t* A; const bf16_t* Bt; int lda, ldb, K; size_t zsA, zsB; };
struct Order {
    int nM, nN, nMz, nwg, G, c;
    __device__ __forceinline__ void init(int nM_, int nN_, int nZ, int G_, int c_) { nM = nM_; nN = nN_; nMz = nM_ * nZ; nwg = nMz * nN; G = G_; c = c_; }
    __device__ __forceinline__ bool next(int i, Unit& u) const {
        const long L = (long)i * G + c; if (c < 0 || L >= nwg) return false;
        int wgid = (int)L; { const int q = nwg / NXCD, r = nwg % NXCD, xcd = wgid % NXCD, off = wgid / NXCD; wgid = (xcd < r ? xcd * (q + 1) : r * (q + 1) + (xcd - r) * q) + off; }
        const int nig = WGM * nN, gid = wgid / nig, fm = gid * WGM, gsz = (nMz - fm) < WGM ? (nMz - fm) : WGM;
        const int pmz = fm + ((wgid % nig) % gsz); u.pn = (wgid % nig) / gsz; u.z = pmz / nM; u.pm = pmz % nM; return true;
    }
    __device__ __forceinline__ void a_ready(const Unit&) const {}
    __device__ __forceinline__ void done(const Unit&) const {}
};

struct StoreEpi {
    static constexpr bool PERM = true, AFTER_DRAIN = false, INIT_ACC = false;
    int mode;
    bf16_t* O0; int ld0; float s0; int split; bf16_t* O1; int ld1; int zrows; int coff;
    __device__ __forceinline__ void operator()(const f32x4 (&acc)[2][2][4][2], const Unit& u, int wr, int wc, int fr, int fq) const {
        if (mode >= 3) {
#pragma unroll
            for (int m = 0; m < 4; ++m) {
                int kq = m * 16 + fr;
                asm volatile("" : "+v"(kq) :: "memory");
#pragma unroll
                for (int bj = 0; bj < 2; ++bj) {
                    const int R = u.pn * BM + bj * HALF + wc * 32 + 8 * fq;
                    if (mode == 3) {
                        const int col = R >> 5, n2 = (R & 31) + 32 * wr, b = col >> 10, colb = col & 1023;
                        bf16_t* p = O0 + ((size_t)((b * 32 + (kq & 31)) * 1024 + colb)) * 256 + (kq >> 5) * 128 + n2;
#pragma unroll
                        for (int nn = 0; nn < 2; ++nn) {
                            const f32x4 a = acc[0][bj][m][nn], bb = acc[1][bj][m][nn]; float tr[4], ti[4];
#pragma unroll
                            for (int i = 0; i < 4; ++i) { const float x = (float)((n2 + 4 * nn + i) * kq) * (1.f / 4096.f); const float ct = __builtin_amdgcn_cosf(x), st = __builtin_amdgcn_sinf(x);
                                tr[i] = a[i] * ct + bb[i] * st; ti[i] = bb[i] * ct - a[i] * st; }
                            u32x2 w; w.x = cvt_pk_bf16(tr[0], tr[1]); w.y = cvt_pk_bf16(tr[2], tr[3]); *(u32x2*)(p + 4 * nn) = w;
                            w.x = cvt_pk_bf16(ti[0], ti[1]); w.y = cvt_pk_bf16(ti[2], ti[3]); *(u32x2*)(p + 64 + 4 * nn) = w;
                            asm volatile("" ::: "memory");
                        }
                    } else {
                        const int b = R >> 15, k1lo = (R >> 10) & 31, colb = R & 1023;
                        const f32x4 v0 = acc[0][bj][m][0], v1 = acc[0][bj][m][1];
                        u32x4 w; w.x = cvt_pk_bf16(v0[0], v0[1]); w.y = cvt_pk_bf16(v0[2], v0[3]); w.z = cvt_pk_bf16(v1[0], v1[1]); w.w = cvt_pk_bf16(v1[2], v1[3]);
                        *(u32x4*)(O0 + (size_t)(b * 4096 + k1lo + 32 * wr + 64 * kq) * 1024 + colb) = w;
                    }
                }
                asm volatile("" ::: "memory");
            }
            return;
        }
#pragma unroll
        for (int ai = 0; ai < 2; ++ai)
#pragma unroll
            for (int m = 0; m < 4; ++m) {
                const int r = u.pm * BM + ai * HALF + wr * 64 + m * 16 + fr;
#pragma unroll
                for (int bj = 0; bj < 2; ++bj) {
                    const int c = u.pn * BM + bj * HALF + wc * 32 + 8 * fq;
                    bf16_t* p; float sc = 1.f;
                    if (mode == 0) { if (c < split) { p = O0 + (size_t)(u.z * zrows + r) * ld0 + c; sc = s0; } else p = O1 + (size_t)r * ld1 + (c - split); }
                    else if (mode == 1) { int b, key; tok_bk(c + coff, b, key); p = O0 + (size_t)(b * DM + r) * NKEY + key; }
                    else { const int ri = r >> 8, k2 = r & 255, b = c >> 12, pp = c & 4095; p = O0 + (size_t)((b * 4 + u.z) * 256 + k2) * 8192 + (pp >> 6) * 128 + ri * 64 + (pp & 63); }
                    const f32x4 v0 = acc[ai][bj][m][0] * sc, v1 = acc[ai][bj][m][1] * sc;
                    u32x4 w; w.x = cvt_pk_bf16(v0[0], v0[1]); w.y = cvt_pk_bf16(v0[2], v0[3]); w.z = cvt_pk_bf16(v1[0], v1[1]); w.w = cvt_pk_bf16(v1[2], v1[3]);
                    *(u32x4*)p = w;
                }
                asm volatile("" ::: "memory");
            }
    }
};
struct PairEpi {
    static constexpr bool PERM = true, AFTER_DRAIN = false, INIT_ACC = false;
    int act;
    int pn0; bf16_t* O0; int ld0; bf16_t* O1; int ld1;
    int fuse; const float* rowss; const float* shw;
    __device__ __forceinline__ void operator()(const f32x4 (&acc)[2][2][4][2], const Unit& u, int wr, int wc, int fr, int fq) const {
        if (u.pn < pn0) {
#pragma unroll
            for (int ai = 0; ai < 2; ++ai)
#pragma unroll
                for (int m = 0; m < 4; ++m) {
                    const int r = u.pm * BM + ai * HALF + wr * 64 + m * 16 + fr;
#pragma unroll
                    for (int bj = 0; bj < 2; ++bj) {
                        const int c = u.pn * BM + bj * HALF + wc * 32 + 8 * fq;
                        const f32x4 v0 = acc[ai][bj][m][0], v1 = acc[ai][bj][m][1];
                        u32x4 w; w.x = cvt_pk_bf16(v0[0], v0[1]); w.y = cvt_pk_bf16(v0[2], v0[3]); w.z = cvt_pk_bf16(v1[0], v1[1]); w.w = cvt_pk_bf16(v1[2], v1[3]);
                        *(u32x4*)(O0 + (size_t)r * ld0 + c) = w;
                    }
                    asm volatile("" ::: "memory");
                }
        } else {
            const int c = (u.pn - pn0) * HALF + wc * 32 + 8 * fq;
            f32x4 shg[2], shu[2];
            if (fuse) { const int r0 = u.pm * BM; const float* sp = shw + (r0 < ML ? (r0 >> 12) : 5) * (2 * FH) + u.pn * BM + wc * 32 + 8 * fq;
                shg[0] = *(const f32x4*)sp; shg[1] = *(const f32x4*)(sp + 4); shu[0] = *(const f32x4*)(sp + HALF); shu[1] = *(const f32x4*)(sp + HALF + 4); }
            float rsv[2][4];
#pragma unroll
            for (int ai = 0; ai < 2; ++ai)
#pragma unroll
                for (int m = 0; m < 4; ++m) { const int r = u.pm * BM + ai * HALF + wr * 64 + m * 16 + fr; rsv[ai][m] = (fuse && r < ML) ? rowss[r] : 0.f; }
#pragma unroll
            for (int ai = 0; ai < 2; ++ai)
#pragma unroll
                for (int m = 0; m < 4; ++m) rsv[ai][m] = (fuse && u.pm * BM < ML) ? rsqrtf(rsv[ai][m] * (1.f / DM) + NORM_EPS) : 1.f;
#pragma unroll
            for (int ai = 0; ai < 2; ++ai)
#pragma unroll
                for (int m = 0; m < 4; ++m) {
                    const int r = u.pm * BM + ai * HALF + wr * 64 + m * 16 + fr;
                    const float rs = rsv[ai][m];
                    f32x4 v[2];
#pragma unroll
                    for (int n = 0; n < 2; ++n) {
                        f32x4 a = acc[ai][0][m][n], b = acc[ai][1][m][n];
                        if (fuse) { a = a * rs + shg[n]; b = b * rs + shu[n]; }
                        if (act == 1) { v[n] = (f32x4){silu_f(a[0]) * b[0], silu_f(a[1]) * b[1], silu_f(a[2]) * b[2], silu_f(a[3]) * b[3]}; }
                        else v[n] = a * b;
                    }
                    u32x4 w; w.x = cvt_pk_bf16(v[0][0], v[0][1]); w.y = cvt_pk_bf16(v[0][2], v[0][3]); w.z = cvt_pk_bf16(v[1][0], v[1][1]); w.w = cvt_pk_bf16(v[1][2], v[1][3]);
                    *(u32x4*)(O1 + (size_t)r * ld1 + c) = w;
                    asm volatile("" ::: "memory");
                }
        }
    }
};
struct ResidEpi {
    static constexpr bool PERM = false, AFTER_DRAIN = false, INIT_ACC = true;
    __device__ __forceinline__ static f32x4 gclamp(f32x4 g) { f32x4 r;
#pragma unroll
        for (int i = 0; i < 4; ++i) r[i] = fabsf(g[i]) < 1e-12f ? 1e-12f : g[i];
        return r; }
    __device__ __forceinline__ void init(f32x4 (&acc)[2][2][4][2], const Unit& u, int wr, int wc, int fr, int fq, float zf) const {
        if (atomic) {
#pragma unroll
            for (int a = 0; a < 2; ++a)
#pragma unroll
                for (int b = 0; b < 2; ++b)
#pragma unroll
                    for (int m = 0; m < 4; ++m)
#pragma unroll
                        for (int n = 0; n < 2; ++n) acc[a][b][m][n] = (f32x4){zf, zf, zf, zf};
            return;
        }
        const int mr = mod_row(rbase + u.pm * BM);
#pragma unroll
        for (int ai = 0; ai < 2; ++ai)
#pragma unroll
            for (int m = 0; m < 4; ++m) { const int r = rbase + u.pm * BM + ai * HALF + wr * 64 + m * 16 + fr;
                const float* s = r < ML ? srcL + (size_t)r * DM : srcC + (size_t)(r - ML) * DM;
#pragma unroll
                for (int bj = 0; bj < 2; ++bj)
#pragma unroll
                    for (int n = 0; n < 2; ++n) acc[ai][bj][m][n] = *(const f32x4*)(s + u.pn * BM + bj * HALF + wc * 32 + 16 * n + 4 * fq); }
#pragma unroll
        for (int bj = 0; bj < 2; ++bj)
#pragma unroll
            for (int n = 0; n < 2; ++n) { const f32x4 gc = gclamp(*(const f32x4*)(gate + mr * 6144 + u.pn * BM + bj * HALF + wc * 32 + 16 * n + 4 * fq));
                const f32x4 gi = (f32x4){1.0f / gc[0], 1.0f / gc[1], 1.0f / gc[2], 1.0f / gc[3]};
#pragma unroll
                for (int ai = 0; ai < 2; ++ai)
#pragma unroll
                    for (int m = 0; m < 4; ++m) acc[ai][bj][m][n] *= gi; }
    }
    const float* srcL; const float* srcC; float* dstL; float* dstC; const float* gate;
    int rbase, atomic; float* part;
    int fuse; bf16_t* Hn; const float* g2; const float* sc2; float* rowss;
    __device__ __forceinline__ void operator()(const f32x4 (&acc)[2][2][4][2], const Unit& u, int wr, int wc, int fr, int fq) const {
        const int mr = mod_row(rbase + u.pm * BM);
        f32x4 gv[2][2], gm[2][2];
#pragma unroll
        for (int bj = 0; bj < 2; ++bj)
#pragma unroll
            for (int n = 0; n < 2; ++n) { const int c = u.pn * BM + bj * HALF + wc * 32 + 16 * n + 4 * fq;
                gv[bj][n] = gclamp(*(const f32x4*)(gate + mr * 6144 + c));
                gm[bj][n] = fuse ? *(const f32x4*)(g2 + c) * (*(const f32x4*)(sc2 + mr * 6144 + c) + 1.0f) : gv[bj][n]; }
#pragma unroll
        for (int ai = 0; ai < 2; ++ai)
#pragma unroll
            for (int m = 0; m < 4; ++m) {
                const int r = rbase + u.pm * BM + ai * HALF + wr * 64 + m * 16 + fr;
                const float* s = r < ML ? srcL + (size_t)r * DM : srcC + (size_t)(r - ML) * DM;
                float* d = r < ML ? dstL + (size_t)r * DM : dstC + (size_t)(r - ML) * DM;
                float ss = 0.f;
#pragma unroll
                for (int bj = 0; bj < 2; ++bj)
#pragma unroll
                    for (int n = 0; n < 2; ++n) {
                        const int c = u.pn * BM + bj * HALF + wc * 32 + 16 * n + 4 * fq;
                        if (atomic) { *(f32x4*)(part + ((size_t)(u.z * MC + (r - ML)) * DM + c)) = acc[ai][bj][m][n]; }
                        else {
                            const f32x4 xn = gv[bj][n] * acc[ai][bj][m][n]; *(f32x4*)(d + c) = xn;
                            if (fuse) { ss += (xn[0] * xn[0] + xn[1] * xn[1]) + (xn[2] * xn[2] + xn[3] * xn[3]); const f32x4 xg = xn * gm[bj][n];
                                u32x2 w; w.x = cvt_pk_bf16(xg[0], xg[1]); w.y = cvt_pk_bf16(xg[2], xg[3]); *(u32x2*)(Hn + (size_t)r * DM + c) = w; }
                        }
                    }
                if (fuse) { ss += SWZ_XOR(ss, 16); ss = xor32_sum(ss); if (fq == 0) unsafeAtomicAdd(rowss + r, ss); }
                if (fuse && (m & 1)) asm volatile("" ::: "memory");
            }
    }
};

template <class Epi, class Sched, bool ALIGN_EPI = false, bool SP2 = false>
__device__ __forceinline__ void gemm_phase(PG8_LAS unsigned char* lds, const Gemm g, const Sched& S, const Epi& E, const int tid) {
    const int wid = __builtin_amdgcn_readfirstlane(tid >> 6), lane = tid & 63, wr = wid >> 2, wc = wid & 3, fr = lane & 15, fq = lane >> 4;
    const int K = g.K, nt = K / BK, lda = g.lda, ldb = g.ldb;
    unsigned voffA[2], voffB[2];
#pragma unroll
    for (int i = 0; i < 2; ++i) { int R, C; stage_rc(tid * 16 + i * 8192, R, C); const int Rb = Epi::PERM ? ((R & ~31) + perm32(R & 31)) : R;
        voffA[i] = (unsigned)(R * lda + C) * 2u; voffB[i] = (unsigned)(Rb * ldb + C) * 2u; }
    const size_t kstep = (size_t)(BK * 2);
    const size_t hstepA = (size_t)HALF * lda * 2, hstepB = (size_t)HALF * ldb * 2;
    const size_t tstepA = 2 * hstepA, tstepB = 2 * hstepB;
    const unsigned ldsw = (unsigned)wid * 1024u;
    const int aoff = lds_byte(wr * 64 + fr, fq * 8), boff = lds_byte(wc * 32 + fr, fq * 8);
#define PG8_SA(b, h) (((b) * 2 + (h)) * HTB)
#define PG8_SB(b, h) ((4 + (b) * 2 + (h)) * HTB)
#define PG8_STAGE(bufoff, gbase, voff) do { _Pragma("unroll") for (int _i = 0; _i < 2; ++_i) \
        __builtin_amdgcn_global_load_lds((const unsigned*)((const char*)(gbase) + (voff)[_i]), (PG8_LAS unsigned*)(lds + (bufoff) + ldsw + _i * 8192), 16, 0, 0); } while (0)
#define PG8_LDA(dst, b, h) do { _Pragma("unroll") for (int m = 0; m < 4; ++m) _Pragma("unroll") for (int k = 0; k < 2; ++k) dst[m][k] = *(const PG8_LAS bf16x8*)(lds + PG8_SA(b, h) + aoff + m * 2048 + k * 1024); } while (0)
#define PG8_LDB(dst, b, h) do { _Pragma("unroll") for (int n = 0; n < 2; ++n) _Pragma("unroll") for (int k = 0; k < 2; ++k) dst[n][k] = *(const PG8_LAS bf16x8*)(lds + PG8_SB(b, h) + boff + n * 2048 + k * 1024); } while (0)
#define PG8_MMA(ai, bj, At, Bt) do { __builtin_amdgcn_s_setprio(1); _Pragma("unroll") for (int m = 0; m < 4; ++m) _Pragma("unroll") for (int n = 0; n < 2; ++n) _Pragma("unroll") for (int k = 0; k < 2; ++k) \
        acc[ai][bj][m][n] = __builtin_amdgcn_mfma_f32_16x16x32_bf16(Bt[n][k], At[m][k], acc[ai][bj][m][n], 0, 0, 0); __builtin_amdgcn_s_setprio(0); } while (0)
#define PG8_WAIT_V(n) asm volatile("s_waitcnt vmcnt(" #n ")" ::: "memory")
#define PG8_WAIT_L(n) asm volatile("s_waitcnt lgkmcnt(" #n ")" ::: "memory")
#define PG8_BAR __builtin_amdgcn_s_barrier()
#define PG8_SCHED __builtin_amdgcn_sched_barrier(0)
    Unit cur, nxt; int ui = 0;
    if (!S.next(0, cur)) return;
    float zf_ = 0.f; asm volatile("" : "+v"(zf_));
    f32x4 acc[2][2][4][2];
    if constexpr (Epi::INIT_ACC) E.init(acc, cur, wr, wc, fr, fq, zf_);
    else {
#pragma unroll
    for (int a = 0; a < 2; ++a)
#pragma unroll
        for (int b = 0; b < 2; ++b)
#pragma unroll
            for (int m = 0; m < 4; ++m)
#pragma unroll
                for (int n = 0; n < 2; ++n) acc[a][b][m][n] = (f32x4){zf_, zf_, zf_, zf_};
    }
    bf16x8 At[4][2], B0[2][2], B1[2][2];
    const char* cA = (const char*)g.A + (size_t)cur.z * g.zsA + (size_t)cur.pm * tstepA; const char* cB = (const char*)g.Bt + (size_t)cur.z * g.zsB + (size_t)cur.pn * tstepB;
    S.a_ready(cur);
    if constexpr (SP2) {
        PG8_STAGE(PG8_SB(0, 0), cB, voffB); PG8_STAGE(PG8_SB(0, 1), cB + hstepB, voffB); PG8_STAGE(PG8_SA(0, 0), cA, voffA); PG8_STAGE(PG8_SA(0, 1), cA + hstepA, voffA);
        if (wr == 1) PG8_BAR;
        PG8_WAIT_V(2); PG8_BAR;
        PG8_STAGE(PG8_SB(1, 0), cB + kstep, voffB); PG8_STAGE(PG8_SA(1, 0), cA + kstep, voffA); PG8_STAGE(PG8_SB(1, 1), cB + hstepB + kstep, voffB);
        PG8_WAIT_V(6); PG8_BAR;
    } else {
        PG8_STAGE(PG8_SB(0, 0), cB, voffB); PG8_STAGE(PG8_SA(0, 0), cA, voffA); PG8_STAGE(PG8_SB(0, 1), cB + hstepB, voffB); PG8_STAGE(PG8_SA(0, 1), cA + hstepA, voffA);
        if (wr == 1) PG8_BAR;
        PG8_WAIT_V(4); PG8_BAR;
        PG8_STAGE(PG8_SB(1, 0), cB + kstep, voffB); PG8_STAGE(PG8_SA(1, 0), cA + kstep, voffA); PG8_STAGE(PG8_SB(1, 1), cB + hstepB + kstep, voffB);
        PG8_WAIT_V(6); PG8_BAR;
    }
    for (;;) {
        const bool has_next = S.next(ui + 1, nxt);
        const char* nA = has_next ? (const char*)g.A + (size_t)nxt.z * g.zsA + (size_t)nxt.pm * tstepA : cA; const char* nB = has_next ? (const char*)g.Bt + (size_t)nxt.z * g.zsB + (size_t)nxt.pn * tstepB : cB;
        for (int t = 0; t < nt; t += 2) {
            const bool last = (t == nt - 2);
            const char* a1 = cA + (size_t)(t + 1) * kstep;
            const char* a2 = last ? nA : cA + (size_t)(t + 2) * kstep; const char* b2 = last ? nB : cB + (size_t)(t + 2) * kstep;
            const char* a3 = a2 + kstep; const char* b3 = b2 + kstep;
            if (last && has_next) S.a_ready(nxt);
            if constexpr (SP2) {
            PG8_LDB(B0, 0, 0); PG8_LDB(B1, 0, 1); PG8_SCHED; PG8_LDA(At, 0, 0); PG8_STAGE(PG8_SA(1, 1), a1 + hstepA, voffA);
            PG8_WAIT_V(8); PG8_WAIT_L(0); PG8_BAR; PG8_MMA(0, 0, At, B0); PG8_MMA(0, 1, At, B1); PG8_BAR; PG8_SCHED;
            PG8_LDA(At, 0, 1); PG8_STAGE(PG8_SB(0, 0), b2, voffB); PG8_STAGE(PG8_SB(0, 1), b2 + hstepB, voffB); PG8_STAGE(PG8_SA(0, 0), a2, voffA);
            PG8_WAIT_V(8); PG8_WAIT_L(0); PG8_BAR; PG8_MMA(1, 0, At, B0); PG8_MMA(1, 1, At, B1); PG8_BAR; PG8_SCHED;
            PG8_LDB(B0, 1, 0); PG8_LDB(B1, 1, 1); PG8_SCHED; PG8_LDA(At, 1, 0); PG8_STAGE(PG8_SA(0, 1), a2 + hstepA, voffA);
            PG8_WAIT_V(8); PG8_WAIT_L(0); PG8_BAR; PG8_MMA(0, 0, At, B0); PG8_MMA(0, 1, At, B1); PG8_BAR; PG8_SCHED;
            PG8_LDA(At, 1, 1); PG8_STAGE(PG8_SB(1, 0), b3, voffB); PG8_STAGE(PG8_SB(1, 1), b3 + hstepB, voffB); PG8_STAGE(PG8_SA(1, 0), a3, voffA);
            PG8_WAIT_V(8); PG8_WAIT_L(0); PG8_BAR; PG8_MMA(1, 0, At, B0); PG8_MMA(1, 1, At, B1); PG8_BAR; PG8_SCHED;
            } else {
            PG8_LDB(B0, 0, 0); PG8_SCHED; PG8_LDA(At, 0, 0); PG8_STAGE(PG8_SA(1, 1), a1 + hstepA, voffA);
            PG8_WAIT_L(8); PG8_BAR; PG8_WAIT_L(0); PG8_MMA(0, 0, At, B0); PG8_BAR; PG8_SCHED;
            PG8_LDB(B1, 0, 1); PG8_STAGE(PG8_SB(0, 0), b2, voffB);
            PG8_BAR; PG8_WAIT_L(0); PG8_MMA(0, 1, At, B1); PG8_BAR;
            PG8_LDA(At, 0, 1); PG8_STAGE(PG8_SA(0, 0), a2, voffA);
            PG8_BAR; PG8_WAIT_L(0); PG8_MMA(1, 0, At, B0); PG8_BAR; PG8_SCHED;
            PG8_STAGE(PG8_SB(0, 1), b2 + hstepB, voffB);
            PG8_WAIT_V(6); PG8_BAR; PG8_MMA(1, 1, At, B1); PG8_BAR;
            PG8_LDB(B0, 1, 0); PG8_SCHED; PG8_LDA(At, 1, 0); PG8_STAGE(PG8_SA(0, 1), a2 + hstepA, voffA);
            PG8_WAIT_L(8); PG8_BAR; PG8_WAIT_L(0); PG8_MMA(0, 0, At, B0); PG8_BAR; PG8_SCHED;
            PG8_LDB(B1, 1, 1); PG8_STAGE(PG8_SB(1, 0), b3, voffB);
            PG8_BAR; PG8_WAIT_L(0); PG8_MMA(0, 1, At, B1); PG8_BAR;
            PG8_LDA(At, 1, 1); PG8_STAGE(PG8_SA(1, 0), a3, voffA);
            PG8_BAR; PG8_WAIT_L(0); PG8_MMA(1, 0, At, B0); PG8_BAR; PG8_SCHED;
            PG8_STAGE(PG8_SB(1, 1), b3 + hstepB, voffB);
            PG8_WAIT_V(6); PG8_BAR; PG8_MMA(1, 1, At, B1); PG8_BAR;
            }
        }
        if constexpr (ALIGN_EPI) { if (wr == 0) PG8_BAR; }
        if constexpr (!Epi::AFTER_DRAIN) { E(acc, cur, wr, wc, fr, fq); S.done(cur); }
        if (!has_next) break;
        if constexpr (Epi::INIT_ACC) E.init(acc, nxt, wr, wc, fr, fq, zf_);
        else {
#pragma unroll
        for (int a = 0; a < 2; ++a)
#pragma unroll
            for (int b = 0; b < 2; ++b)
#pragma unroll
                for (int m = 0; m < 4; ++m)
#pragma unroll
                    for (int n = 0; n < 2; ++n) acc[a][b][m][n] = (f32x4){zf_, zf_, zf_, zf_};
        }
        cur = nxt; cA = nA; cB = nB; ++ui;
        if constexpr (ALIGN_EPI) { if (wr == 1) PG8_BAR; }
    }
    PG8_WAIT_V(0);
    if constexpr (!ALIGN_EPI) { if (wr == 0) PG8_BAR; }
    PG8_BAR;
    if constexpr (Epi::AFTER_DRAIN) { E.fused(acc, cur, wr, wc, fr, fq, lds, wid, lane); S.done(cur); }
#undef PG8_SA
#undef PG8_SB
#undef PG8_STAGE
#undef PG8_LDA
#undef PG8_LDB
#undef PG8_MMA
#undef PG8_WAIT_V
#undef PG8_WAIT_L
#undef PG8_BAR
#undef PG8_SCHED
}
}

constexpr size_t MiB = (size_t)1 << 20;
constexpr size_t WS_MOD = 0;
constexpr size_t WS_ROPE = 1 * MiB;
constexpr size_t WS_DFTA = 2 * MiB;
constexpr size_t WS_KR = 3 * MiB;
constexpr size_t WS_XC = 5 * MiB;
constexpr size_t WS_CONV_IN = 9 * MiB, WS_CONV_OUT = 15 * MiB, WS_NAT_QK = 17 * MiB, WS_NAT_V = 21 * MiB, WS_NAT_O = 23 * MiB;
constexpr size_t WS_MLA_A = 25 * MiB, WS_MLA_UQ = 27 * MiB, WS_MLA_K = 28 * MiB, WS_MLA_V = 29 * MiB, WS_MLA_O = 30 * MiB, WS_FNET_O = 32 * MiB;
constexpr size_t WS_FFN_IN = 34 * MiB, FFN_IN_STRIDE = 11 * MiB, WS_FFN_OUT = 78 * MiB, FFN_OUT_STRIDE = (size_t)DM * FH * 2;
constexpr size_t WS_DFTB = 100 * MiB;
constexpr size_t WS_H = 164 * MiB;
constexpr size_t WS_BIG = 198 * MiB;
constexpr size_t WS_ZG = 300 * MiB;
constexpr size_t WS_VT = 334 * MiB;
constexpr size_t WS_SHW = 368 * MiB;
constexpr size_t WS_END = 369 * MiB;
constexpr size_t WS_ROWSS = 576 * 1024;
constexpr size_t SUB = 34 * MiB;

struct Params {
    const float* in[25];
    float* out; unsigned char* ws;
    int ph_lo, ph_hi;
};
enum { I_X = 0, I_C, I_CTX, I_CCTX, I_MODW, I_MODB, I_MIXG, I_FFNG, I_CONV_IN, I_CONV_W, I_CONV_OUT, I_NAT_QKV, I_NAT_RPB, I_NAT_O,
       I_MLA_DQ, I_MLA_QG, I_MLA_UQ, I_MLA_DKV, I_MLA_KVG, I_MLA_UKV, I_MLA_O, I_FNET_O, I_FFN_IN, I_FFN_OUT, I_FINAL_G };

__device__ __forceinline__ unsigned f2bf(float f) { unsigned u = __float_as_uint(f); return (u + 0x7fffu + ((u >> 16) & 1u)) >> 16; }
__device__ __forceinline__ unsigned pk2(float lo, float hi) { return f2bf(lo) | (f2bf(hi) << 16); }

struct TrItem { const float* src; bf16_t* dst; int N, K; };
__device__ __forceinline__ TrItem transpose_decode(const float* W, int K, int N, int kind, bf16_t* D0, bf16_t* D1, int item) {
    const int nblk = N / 32, kb = item / nblk, nb = item % nblk, k0 = 64 * kb, n0 = 32 * nb;
    bf16_t* D = D0; int drow = n0;
    if (kind == 1) { const int j = n0 < FH ? n0 : n0 - FH; drow = 256 * (j / 128) + (j % 128) + (n0 < FH ? 0 : 128); }
    else if (kind == 2) { if (n0 >= 1024) { const int j = (n0 - 1024) & 1023; drow = 1024 + 256 * (j / 128) + (j % 128) + (n0 >= 2048 ? 128 : 0); } }
    else if (kind == 3) { if (n0 >= 2048) { D = D1; drow = n0 - 2048; } }
    else if (kind == 6) { const int hh = n0 / 96, t = (n0 % 96) / 32; drow = t < 2 ? hh * 64 + 32 * t : 1024 + hh * 32; }
    else if (kind == 7) { const int hh = n0 / 128, j = n0 % 128; if (j < 64) drow = hh * 64 + j; else { D = D1; drow = hh * 64 + j - 64; } }
    TrItem t; t.src = W + (size_t)k0 * N + n0; t.dst = D + (size_t)drow * K + k0; t.N = N; t.K = K; return t;
}
__device__ __forceinline__ void transpose_load(const TrItem& t, float (&wv)[32], int lane) {
#pragma unroll
    for (int i = 0; i < 32; ++i) wv[i] = __builtin_nontemporal_load(t.src + (size_t)(2 * i + (lane >> 5)) * t.N + (lane & 31));
}
__device__ __forceinline__ void transpose_finish(const TrItem& t, const float (&wv)[32], LAS float* scr, int lane) {
#pragma unroll
    for (int i = 0; i < 32; ++i) scr[(2 * i + (lane >> 5)) * 33 + (lane & 31)] = wv[i];
    asm volatile("s_waitcnt lgkmcnt(0)" ::: "memory");
    const int c = lane & 7;
#pragma unroll
    for (int j = 0; j < 4; ++j) { const int n = (lane >> 3) + 8 * j; const LAS float* s = scr + (8 * c) * 33 + n;
        u32x4 o; o.x = pk2(s[0 * 33], s[1 * 33]); o.y = pk2(s[2 * 33], s[3 * 33]); o.z = pk2(s[4 * 33], s[5 * 33]); o.w = pk2(s[6 * 33], s[7 * 33]);
        *(u32x4*)(t.dst + (size_t)n * t.K + 8 * c) = o; }
    asm volatile("s_waitcnt lgkmcnt(0)" ::: "memory");
}

__device__ __forceinline__ void prep_phase(const Params& p, unsigned char* ws, LAS unsigned char* lds, int G, int bid, int tid, int wid, int lane) {
    {
        LAS float* sc = (LAS float*)lds;
        LAS float* red = (LAS float*)(lds + 20480);
        for (int idx = tid; idx < 5 * 1024; idx += 512) { const int r = idx >> 10, k = idx & 1023; const float v = r < 4 ? p.in[I_C][r * 1024 + k] : p.in[I_CCTX][k]; sc[idx] = silu_f(v); }
        __syncthreads();
        for (int item = bid; item < 256; item += G) {
        const int layer = item >> 6, chunk = item & 63;
        const bool act = lane < 48;
        const float* W = p.in[I_MODW] + (size_t)layer * 1024 * 6144 + chunk * 96 + 2 * (act ? lane : 0);
        float a[5][2];
#pragma unroll
        for (int r = 0; r < 5; ++r) { a[r][0] = 0.f; a[r][1] = 0.f; }
        const int kbeg = wid * 128;
        for (int k0 = kbeg; k0 < kbeg + 128; k0 += 32) {
            f32x2 w[32];
#pragma unroll
            for (int i = 0; i < 32; ++i) w[i] = __builtin_nontemporal_load((const f32x2*)(W + (size_t)(k0 + i) * 6144));
#pragma unroll
            for (int i = 0; i < 32; ++i)
#pragma unroll
                for (int r = 0; r < 5; ++r) { const float s = sc[r * 1024 + k0 + i]; a[r][0] += s * w[i].x; a[r][1] += s * w[i].y; }
        }
        if (act) {
#pragma unroll
            for (int r = 0; r < 5; ++r) { red[(wid * 5 + r) * 96 + 2 * lane] = a[r][0]; red[(wid * 5 + r) * 96 + 2 * lane + 1] = a[r][1]; }
        }
        __syncthreads();
        {
            for (int idx = tid; idx < 480; idx += 512) {
                const int r = idx / 96, cc = idx % 96; float s = 0.f;
#pragma unroll
                for (int w = 0; w < 8; ++w) s += red[(w * 5 + r) * 96 + cc];
                const int col = chunk * 96 + cc;
                ((float*)(ws + WS_MOD))[(layer * 5 + r) * 6144 + col] = s + p.in[I_MODB][layer * 6144 + col];
            }
        }
        __syncthreads();
        }
    }
    {
        LAS float* scr = (LAS float*)(lds + wid * 16384);
        const int gw = bid * 8 + wid, NGW = G * 8;
        constexpr int IT_CONV_IN = 16 * 96, IT_SQ = 16 * 32, IT_DQ = 16 * 8, IT_DKV = 16 * 9, IT_UQ = 4 * 48, IT_UKV = 4 * 64, IT_FIN = 16 * 176, IT_FOUT = 44 * 32;
        constexpr int NITEMS = IT_CONV_IN + IT_SQ + IT_CONV_IN + IT_SQ + IT_DQ + IT_DKV + IT_UQ + IT_UKV + IT_SQ + IT_SQ + 4 * IT_FIN + 4 * IT_FOUT;
#define DECODE_ITEM(it_, T_) do { const int it = (it_); \
            int r = it; const float* W; int K, N, kind = 0; bf16_t* D0; bf16_t* D1 = nullptr; \
            if (r < IT_CONV_IN) { W = p.in[I_CONV_IN]; K = 1024; N = 3072; kind = 2; D0 = (bf16_t*)(ws + WS_CONV_IN); } \
            else if ((r -= IT_CONV_IN) < IT_SQ) { W = p.in[I_CONV_OUT]; K = 1024; N = 1024; D0 = (bf16_t*)(ws + WS_CONV_OUT); } \
            else if ((r -= IT_SQ) < IT_CONV_IN) { W = p.in[I_NAT_QKV]; K = 1024; N = 3072; kind = 3; D0 = (bf16_t*)(ws + WS_NAT_QK); D1 = (bf16_t*)(ws + WS_NAT_V); } \
            else if ((r -= IT_CONV_IN) < IT_SQ) { W = p.in[I_NAT_O]; K = 1024; N = 1024; D0 = (bf16_t*)(ws + WS_NAT_O); } \
            else if ((r -= IT_SQ) < IT_DQ) { W = p.in[I_MLA_DQ]; K = 1024; N = 256; D0 = (bf16_t*)(ws + WS_MLA_A); } \
            else if ((r -= IT_DQ) < IT_DKV) { W = p.in[I_MLA_DKV]; K = 1024; N = 288; D0 = (bf16_t*)(ws + WS_MLA_A) + 256 * 1024; } \
            else if ((r -= IT_DKV) < IT_UQ) { W = p.in[I_MLA_UQ]; K = 256; N = 1536; kind = 6; D0 = (bf16_t*)(ws + WS_MLA_UQ); } \
            else if ((r -= IT_UQ) < IT_UKV) { W = p.in[I_MLA_UKV]; K = 256; N = 2048; kind = 7; D0 = (bf16_t*)(ws + WS_MLA_K); D1 = (bf16_t*)(ws + WS_MLA_V); } \
            else if ((r -= IT_UKV) < IT_SQ) { W = p.in[I_MLA_O]; K = 1024; N = 1024; D0 = (bf16_t*)(ws + WS_MLA_O); } \
            else if ((r -= IT_SQ) < IT_SQ) { W = p.in[I_FNET_O]; K = 1024; N = 1024; D0 = (bf16_t*)(ws + WS_FNET_O); } \
            else if ((r -= IT_SQ) < 4 * IT_FIN) { const int l = r / IT_FIN; r -= l * IT_FIN; W = p.in[I_FFN_IN] + (size_t)l * 1024 * 5632; K = 1024; N = 5632; kind = 1; D0 = (bf16_t*)(ws + WS_FFN_IN + l * FFN_IN_STRIDE); } \
            else { r -= 4 * IT_FIN; const int l = r / IT_FOUT; r -= l * IT_FOUT; W = p.in[I_FFN_OUT] + (size_t)l * FH * 1024; K = FH; N = 1024; D0 = (bf16_t*)(ws + WS_FFN_OUT + l * FFN_OUT_STRIDE); } \
            T_ = transpose_decode(W, K, N, kind, D0, D1, r); } while (0)
        float wvA[32], wvB[32]; TrItem tA, tB; tB = TrItem{nullptr, nullptr, 0, 0};
        if (gw < NITEMS) { DECODE_ITEM(gw, tA); transpose_load(tA, wvA, lane); }
        for (int it0 = gw; it0 < NITEMS; it0 += NGW) {
            const bool hasn = it0 + NGW < NITEMS;
            if (hasn) { DECODE_ITEM(it0 + NGW, tB); transpose_load(tB, wvB, lane); }
            transpose_finish(tA, wvA, scr, lane);
            if (hasn) { tA = tB;
#pragma unroll
                for (int i = 0; i < 32; ++i) wvA[i] = wvB[i]; }
        }
#undef DECODE_ITEM
    }
    const int gt = bid * 512 + tid, NGT = G * 512;
    { const f32x4* s4 = (const f32x4*)p.in[I_CTX]; f32x4* d4 = (f32x4*)(ws + WS_XC); for (int i = gt; i < MC * DM / 4; i += NGT) d4[i] = s4[i]; }
    { float* z = (float*)(ws + WS_ROWSS); for (int i = gt; i < 4 * ML; i += NGT) z[i] = 0.f; }
    { u32x4* z = (u32x4*)((bf16_t*)(ws + WS_MLA_A) + 544 * 1024); unsigned zu_ = 0u; asm volatile("" : "+v"(zu_)); for (int i = gt; i < 224 * 1024 / 8; i += NGT) z[i] = (u32x4){zu_, zu_, zu_, zu_}; }
    { bf16_t* A = (bf16_t*)(ws + WS_DFTA);
      for (int i = gt; i < 512 * 256; i += NGT) { const int f = i >> 8, c = i & 255, k2 = f & 255, ph = (c * k2) & 255; const float x = (float)ph * (1.f / 256.f);
          const float v = f < 256 ? __builtin_amdgcn_cosf(x) * 0.0625f : -__builtin_amdgcn_sinf(x) * 0.0625f; A[i] = (bf16_t)f2bf(v); } }
    { bf16_t* M1 = (bf16_t*)(ws + WS_DFTA) + 512 * 256; bf16_t* M2 = M1 + 256 * 256;
      for (int i = gt; i < 256 * 256; i += NGT) { const int rho = i >> 8, kap = i & 255; const int ro = rho >> 7, hh = (rho >> 6) & 1, ko = rho & 63, hf = kap >> 7, ri = (kap >> 6) & 1, ni = kap & 63;
          const float x = (float)((ni * ko) & 63) * (1.f / 64.f); const float c = __builtin_amdgcn_cosf(x) * 0.125f, s = __builtin_amdgcn_sinf(x) * 0.125f;
          const float v1 = hf != hh ? 0.f : (ro == 0 ? (ri == 0 ? c : s) : (ri == 0 ? -s : c));
          const float v2 = (hf != hh || ro != 0) ? 0.f : (ri == 0 ? c : s);
          M1[i] = (bf16_t)f2bf(v1); M2[i] = (bf16_t)f2bf(v2); } }
    { float* ct = (float*)(ws + WS_ROPE); float* st = ct + 4096 * 16;
      for (int i = gt; i < 4096 * 16; i += NGT) { const int pos = i >> 4, j = i & 15; const float fr = __builtin_amdgcn_exp2f(-(float)(j & 7) * 1.6609640474436812f);
          const float coord = (float)(j < 8 ? (pos >> 6) : (pos & 63)); const float rev = coord * fr * 0.15915494309189535f; ct[i] = __builtin_amdgcn_cosf(rev); st[i] = __builtin_amdgcn_sinf(rev); } }
}

__device__ __forceinline__ void norm_phase(const float* srcL, const float* srcC, int nrows, const float* g, const float* mod, int sh_off, int sc_off, bf16_t* H,
                                           const float* part, int npart, const float* pgate, float* XCw, int perm, int rbeg, int gw, int NGW, int lane) {
    for (int r0 = rbeg + gw; r0 < nrows; r0 += 2 * NGW) {
        const int r1 = r0 + NGW; const bool has1 = r1 < nrows;
        const float* xr0 = r0 < ML ? srcL + (size_t)r0 * DM : srcC + (size_t)(r0 - ML) * DM;
        const int r1c = has1 ? r1 : r0;
        const float* xr1 = r1c < ML ? srcL + (size_t)r1c * DM : srcC + (size_t)(r1c - ML) * DM;
        f32x4 v[2][4];
#pragma unroll
        for (int j = 0; j < 4; ++j) { v[0][j] = *(const f32x4*)(xr0 + (64 * j + lane) * 4); v[1][j] = *(const f32x4*)(xr1 + (64 * j + lane) * 4); }
#pragma unroll
        for (int q = 0; q < 2; ++q) {
            const int r = q ? r1c : r0;
            if (q == 1 && !has1) break;
            if (r >= ML && npart > 0) {
                f32x4 a4[4];
#pragma unroll
                for (int j = 0; j < 4; ++j) a4[j] = (f32x4){0.f, 0.f, 0.f, 0.f};
                for (int z = 0; z < npart; ++z) { const float* pr = part + ((size_t)(z * MC + (r - ML)) * DM);
#pragma unroll
                    for (int j = 0; j < 4; ++j) a4[j] += *(const f32x4*)(pr + (64 * j + lane) * 4); }
#pragma unroll
                for (int j = 0; j < 4; ++j) { v[q][j] += a4[j] * *(const f32x4*)(pgate + (64 * j + lane) * 4); *(f32x4*)(XCw + (size_t)(r - ML) * DM + (64 * j + lane) * 4) = v[q][j]; }
            }
            const float* mp = mod + mod_row(r) * 6144;
            const int nn_ = r & 4095, ro_ = perm ? (r & ~4095) + (nn_ & 31) * 128 + ((nn_ >> 5) & 1) * 64 + (nn_ >> 6) : r;
            float s = 0.f;
#pragma unroll
            for (int j = 0; j < 4; ++j) s += (v[q][j].x * v[q][j].x + v[q][j].y * v[q][j].y) + (v[q][j].z * v[q][j].z + v[q][j].w * v[q][j].w);
            const float rstd = rsqrtf(wave_sum(s) * (1.f / DM) + NORM_EPS);
#pragma unroll
            for (int j = 0; j < 4; ++j) { const int e = (64 * j + lane) * 4;
                const f32x4 gg = *(const f32x4*)(g + e), sc = *(const f32x4*)(mp + sc_off + e), sh = *(const f32x4*)(mp + sh_off + e);
                const f32x4 o = (v[q][j] * rstd) * gg * (sc + 1.0f) + sh;
                u32x2 w; w.x = cvt_pk_bf16(o[0], o[1]); w.y = cvt_pk_bf16(o[2], o[3]); *(u32x2*)(H + (size_t)ro_ * DM + e) = w; }
        }
    }
}
__device__ __forceinline__ void final_norm_phase(float* x, const float* g, int gw, int NGW, int lane) {
    constexpr int NR = 2;
    for (int r0 = gw; r0 < ML; r0 += NR * NGW) {
        f32x4 v[NR][4];
#pragma unroll
        for (int q = 0; q < NR; ++q) { const int rq = r0 + q * NGW; const float* xr = x + (size_t)(rq < ML ? rq : r0) * DM;
#pragma unroll
            for (int j = 0; j < 4; ++j) v[q][j] = *(const f32x4*)(xr + (64 * j + lane) * 4); }
#pragma unroll
        for (int q = 0; q < NR; ++q) {
            const int r = r0 + q * NGW; if (r >= ML) break;
            float* xr = x + (size_t)r * DM; float s = 0.f;
#pragma unroll
            for (int j = 0; j < 4; ++j) s += (v[q][j].x * v[q][j].x + v[q][j].y * v[q][j].y) + (v[q][j].z * v[q][j].z + v[q][j].w * v[q][j].w);
            const float rstd = rsqrtf(wave_sum(s) * (1.f / DM) + NORM_EPS);
#pragma unroll
            for (int j = 0; j < 4; ++j) { const int e = (64 * j + lane) * 4; *(f32x4*)(xr + e) = (v[q][j] * rstd) * *(const f32x4*)(g + e); }
        }
    }
}
#define UNPACK8(V_, f) do { f[0] = bf_lo(V_[0]); f[1] = bf_hi(V_[0]); f[2] = bf_lo(V_[1]); f[3] = bf_hi(V_[1]); f[4] = bf_lo(V_[2]); f[5] = bf_hi(V_[2]); f[6] = bf_lo(V_[3]); f[7] = bf_hi(V_[3]); } while (0)
__device__ __forceinline__ void conv_phase(const bf16_t* Bg, const bf16_t* U, const float* cw, bf16_t* ZG, int gw, int NGW, int lane) {
    for (int r0 = gw; r0 < MT; r0 += 2 * NGW) {
        u32x4 bgw[2][2], u0w[2][2], umw[2][2], upw[2][2];
        unsigned zu_ = 0u; asm volatile("" : "+v"(zu_)); const u32x4 zero = {zu_, zu_, zu_, zu_};
#pragma unroll
        for (int q = 0; q < 2; ++q) { const int rq = r0 + q * NGW; const int r = rq < MT ? rq : r0;
            int s, last; if (r < ML) { s = r & 4095; last = 4095; } else { s = (r - ML) & 255; last = 255; }
            const bool hasp = s > 0, hasn = s < last;
#pragma unroll
            for (int half = 0; half < 2; ++half) { const size_t o = (size_t)r * DM + (half * 64 + lane) * 8;
                bgw[q][half] = *(const u32x4*)(Bg + o); u0w[q][half] = *(const u32x4*)(U + o);
                umw[q][half] = hasp ? *(const u32x4*)(U + o - DM) : zero; upw[q][half] = hasn ? *(const u32x4*)(U + o + DM) : zero; } }
#pragma unroll
        for (int q = 0; q < 2; ++q) { const int r = r0 + q * NGW; if (r >= MT) break;
#pragma unroll
            for (int half = 0; half < 2; ++half) {
                const int e = (half * 64 + lane) * 8; const size_t o = (size_t)r * DM + e;
                float bg[8], u0[8], um[8], up[8], z[8]; UNPACK8(bgw[q][half], bg); UNPACK8(u0w[q][half], u0); UNPACK8(umw[q][half], um); UNPACK8(upw[q][half], up);
#pragma unroll
                for (int k4 = 0; k4 < 2; ++k4) { const f32x4 w0 = *(const f32x4*)(cw + e + 4 * k4), w1 = *(const f32x4*)(cw + DM + e + 4 * k4), w2 = *(const f32x4*)(cw + 2 * DM + e + 4 * k4);
#pragma unroll
                    for (int k = 0; k < 4; ++k) z[4 * k4 + k] = bg[4 * k4 + k] * (w0[k] * um[4 * k4 + k] + w1[k] * u0[4 * k4 + k] + w2[k] * up[4 * k4 + k]); }
                u32x4 w; w.x = cvt_pk_bf16(z[0], z[1]); w.y = cvt_pk_bf16(z[2], z[3]); w.z = cvt_pk_bf16(z[4], z[5]); w.w = cvt_pk_bf16(z[6], z[7]);
                *(u32x4*)(ZG + o) = w;
            }
        }
    }
}
__device__ __forceinline__ void mla_thin_phase(const bf16_t* CQ, const float* qg, const float* kvg, const float* cosT, const float* sinT, bf16_t* cqn, bf16_t* ckvn, bf16_t* Kr, int gw, int NGW, int lane) {
    for (int r = gw; r < MT; r += NGW) {
        const bf16_t* row = CQ + (size_t)r * 768;
        const u32x2 a = *(const u32x2*)(row + 4 * lane), b = *(const u32x2*)(row + 256 + 4 * lane);
        const float a0 = bf_lo(a.x), a1 = bf_hi(a.x), a2 = bf_lo(a.y), a3 = bf_hi(a.y), b0 = bf_lo(b.x), b1 = bf_hi(b.x), b2 = bf_lo(b.y), b3 = bf_hi(b.y);
        const float ra = rsqrtf(wave_sum(a0 * a0 + a1 * a1 + a2 * a2 + a3 * a3) * (1.f / 256.f) + NORM_EPS);
        const float rb = rsqrtf(wave_sum(b0 * b0 + b1 * b1 + b2 * b2 + b3 * b3) * (1.f / 256.f) + NORM_EPS);
        const f32x4 g1 = *(const f32x4*)(qg + 4 * lane), g2 = *(const f32x4*)(kvg + 4 * lane);
        u32x2 w; w.x = cvt_pk_bf16(a0 * ra * g1[0], a1 * ra * g1[1]); w.y = cvt_pk_bf16(a2 * ra * g1[2], a3 * ra * g1[3]); *(u32x2*)(cqn + (size_t)r * 256 + 4 * lane) = w;
        w.x = cvt_pk_bf16(b0 * rb * g2[0], b1 * rb * g2[1]); w.y = cvt_pk_bf16(b2 * rb * g2[2], b3 * rb * g2[3]); *(u32x2*)(ckvn + (size_t)r * 256 + 4 * lane) = w;
        if (lane < 16) {
            const float x1 = __uint_as_float((unsigned)row[512 + lane] << 16), x2 = __uint_as_float((unsigned)row[528 + lane] << 16);
            float o1 = x1, o2 = x2;
            if (r < ML) { const int pos = r & 4095; const float cs = cosT[pos * 16 + lane], sn = sinT[pos * 16 + lane]; o1 = x1 * cs - x2 * sn; o2 = x1 * sn + x2 * cs; }
            Kr[(size_t)r * 32 + lane] = (bf16_t)f2bf(o1); Kr[(size_t)r * 32 + 16 + lane] = (bf16_t)f2bf(o2);
        }
    }
}

__device__ __forceinline__ void shw_phase(const float* MOD, const unsigned char* ws, float* SHW, int gw, int NGW, int lane) {
    for (int it = gw; it < 4 * 2 * FH; it += NGW) {
        const int L = it / (2 * FH), n = it % (2 * FH);
        const bf16_t* wrow = (const bf16_t*)(ws + WS_FFN_IN + L * FFN_IN_STRIDE) + (size_t)n * DM;
        const u32x4 w0 = *(const u32x4*)(wrow + 8 * lane), w1 = *(const u32x4*)(wrow + 512 + 8 * lane);
        float wf[16]; UNPACK8(w0, wf); { float* wf8 = wf + 8; UNPACK8(w1, wf8); }
#pragma unroll
        for (int mr = 0; mr < 5; ++mr) {
            const float* sh = MOD + (L * 5 + mr) * 6144 + 3072;
            float acc = 0.f;
#pragma unroll
            for (int q = 0; q < 2; ++q) { const f32x4 s0 = *(const f32x4*)(sh + 512 * q + 8 * lane), s1 = *(const f32x4*)(sh + 512 * q + 8 * lane + 4);
                acc += (s0[0] * wf[8 * q] + s0[1] * wf[8 * q + 1]) + (s0[2] * wf[8 * q + 2] + s0[3] * wf[8 * q + 3]) + (s1[0] * wf[8 * q + 4] + s1[1] * wf[8 * q + 5]) + (s1[2] * wf[8 * q + 6] + s1[3] * wf[8 * q + 7]); }
            acc = wave_sum(acc);
            if (lane == 0) SHW[(size_t)(L * 6 + mr) * (2 * FH) + n] = acc;
        }
        if (lane == 0) SHW[(size_t)(L * 6 + 5) * (2 * FH) + n] = 0.f;
    }
}

template <int MODE>
__device__ __forceinline__ void attn_tile(const LAS unsigned char* bufp, LAS unsigned char* lds, const bf16x8 (&qf)[MODE == 0 ? 6 : 4], f32x16 (&o)[2], f32x16& negm, float& m_ref, float& lsum, bool& started,
                                          bool band, int rr, int qrow, int qc, int c0, int prow, int l32, int hi) {
    constexpr int DQ = MODE == 0 ? 96 : 64, NKS = DQ / 16, KP = DQ * 2 + 16, VP = 144, KBYTES = 64 * KP;
    constexpr int BIAS_OFF = 98304;
            const LAS unsigned char* kp = bufp;
            const LAS unsigned char* vp = kp + KBYTES;
            f32x16 s[2];
            bf16x8 kf[NKS][2];
#pragma unroll
            for (int ks = 0; ks < NKS; ++ks)
#pragma unroll
                for (int kh = 0; kh < 2; ++kh) kf[ks][kh] = *(const LAS bf16x8*)(kp + (32 * kh + prow) * KP + (16 * ks + 8 * hi) * 2);
            __builtin_amdgcn_sched_barrier(0);
            __builtin_amdgcn_s_setprio(1);
#pragma unroll
            for (int ks = 0; ks < NKS; ++ks)
#pragma unroll
                for (int kh = 0; kh < 2; ++kh) s[kh] = __builtin_amdgcn_mfma_f32_32x32x16_bf16(kf[ks][kh], qf[ks], ks == 0 ? negm : s[kh], 0, 0, 0);
            __builtin_amdgcn_s_setprio(0);
            if (MODE == 1 && band) {
                const LAS float* bl = (const LAS float*)(lds + BIAS_OFF) + (rr - qrow + 7) * 128 + (63 - qc + 8 * hi);
#pragma unroll
                for (int kh = 0; kh < 2; ++kh)
#pragma unroll
                    for (int i = 0; i < 16; ++i) { const int kcl = 32 * kh + 16 * (i >> 3) + (i & 7); const int kc = kcl + 8 * hi;
                        const bool valid = (unsigned)(kc - c0) < 16u; s[kh][i] = valid ? s[kh][i] + bl[kcl] : -1.0e30f; }
            }
            float mx = fmaxf(s[0][0], s[1][0]);
#pragma unroll
            for (int i = 1; i < 16; ++i) mx = fmaxf(fmaxf(mx, s[0][i]), s[1][i]);
            mx = xor32_max(mx);
            const float delta = (!started || mx > 8.0f) ? mx : 0.f;
            if (__builtin_amdgcn_ballot_w64(delta != 0.f) != 0ull) {
                const float alpha = started ? __builtin_amdgcn_exp2f(-delta) : 1.0f;
                lsum *= alpha; m_ref += delta;
#pragma unroll
                for (int i = 0; i < 16; ++i) negm[i] = -m_ref;
#pragma unroll
                for (int i = 0; i < 16; ++i) { o[0][i] *= alpha; o[1][i] *= alpha; s[0][i] -= delta; s[1][i] -= delta; }
            }
            started = true;
            bf16x8 vf[2][2][2];
#pragma unroll
            for (int kh = 0; kh < 2; ++kh)
#pragma unroll
                for (int t = 0; t < 2; ++t)
#pragma unroll
                    for (int dh = 0; dh < 2; ++dh) vf[kh][t][dh] = *(const LAS bf16x8*)(vp + (32 * dh + l32) * VP + (32 * kh + 16 * t + 8 * hi) * 2);
            __builtin_amdgcn_sched_barrier(0);
            float ps = 0.f;
#pragma unroll
            for (int kh = 0; kh < 2; ++kh)
#pragma unroll
                for (int i = 0; i < 16; ++i) { const float pv = __builtin_amdgcn_exp2f(s[kh][i]); s[kh][i] = pv; ps += pv; }
            lsum += ps;
            bf16x8 pf[2][2];
#pragma unroll
            for (int kh = 0; kh < 2; ++kh)
#pragma unroll
                for (int t = 0; t < 2; ++t) { u32x4 w; w.x = cvt_pk_bf16(s[kh][8 * t + 0], s[kh][8 * t + 1]); w.y = cvt_pk_bf16(s[kh][8 * t + 2], s[kh][8 * t + 3]);
                    w.z = cvt_pk_bf16(s[kh][8 * t + 4], s[kh][8 * t + 5]); w.w = cvt_pk_bf16(s[kh][8 * t + 6], s[kh][8 * t + 7]); pf[kh][t] = __builtin_bit_cast(bf16x8, w); }
#pragma unroll
            for (int kh = 0; kh < 2; ++kh)
#pragma unroll
                for (int t = 0; t < 2; ++t)
#pragma unroll
                    for (int dh = 0; dh < 2; ++dh) { __builtin_amdgcn_s_setprio(1); o[dh] = __builtin_amdgcn_mfma_f32_32x32x16_bf16(vf[kh][t][dh], pf[kh][t], o[dh], 0, 0, 0); __builtin_amdgcn_s_setprio(0); }
}
template <int MODE>
__device__ __forceinline__ void attn_unit(LAS unsigned char* lds, int b, int h, int uq, const bf16_t* Qn, const bf16_t* Qr, const bf16_t* Kn, const bf16_t* Kr, const bf16_t* Vt,
                                          bf16_t* O, const float* rpb_h, const float* cosT, const float* sinT, float qscale, int tid, int wid, int lane) {
    constexpr int DQ = MODE == 0 ? 96 : 64, NKS = DQ / 16, KP = DQ * 2 + 16, VP = 144, KBYTES = 64 * KP, BUFB = KBYTES + 64 * VP;
    constexpr int BIAS_OFF = 98304;
    const int l32 = lane & 31, hi = lane >> 5;
    int q0, T, nb = 0, R0 = 0, qrow = 0, r0w = 0, qc = 0, c0 = 0;
    if (MODE == 0) { q0 = b * SEQ + uq * 256 + wid * 32; T = NKEY / 64; }
    else if (MODE == 1) { qrow = 4 * uq + (wid >> 1); q0 = b * SEQ + qrow * 64 + 32 * (wid & 1);
        R0 = min(max(4 * uq - 4, 0), 56); const int lastr = min(max(4 * uq - 1, 0), 56) + 7; nb = lastr - R0 + 1; T = nb + 4;
        r0w = min(max(qrow - 4, 0), 56); qc = 32 * (wid & 1) + l32; c0 = min(max(qc - 8, 0), 48); }
    else { q0 = ML + b * CTXL + wid * 32; T = 4; }
    bf16x8 qf[NKS];
#pragma unroll
    for (int ks = 0; ks < 4; ++ks) qf[ks] = *(const bf16x8*)(Qn + (size_t)(q0 + l32) * 1024 + h * 64 + 16 * ks + 8 * hi);
    if (MODE == 0) {
        const u32x4 r1 = *(const u32x4*)(Qr + (size_t)(q0 + l32) * 512 + h * 32 + 8 * hi), r2 = *(const u32x4*)(Qr + (size_t)(q0 + l32) * 512 + h * 32 + 16 + 8 * hi);
        const int pos = (q0 + l32) & 4095;
        const f32x4 ca = *(const f32x4*)(cosT + pos * 16 + 8 * hi), cb = *(const f32x4*)(cosT + pos * 16 + 8 * hi + 4);
        const f32x4 sa = *(const f32x4*)(sinT + pos * 16 + 8 * hi), sb = *(const f32x4*)(sinT + pos * 16 + 8 * hi + 4);
        u32x4 w1, w2;
#pragma unroll
        for (int i = 0; i < 4; ++i) {
            const float x1l = bf_lo(r1[i]), x1h = bf_hi(r1[i]), x2l = bf_lo(r2[i]), x2h = bf_hi(r2[i]);
            const float cl = i < 2 ? ca[2 * i] : cb[2 * i - 4], ch = i < 2 ? ca[2 * i + 1] : cb[2 * i - 3];
            const float sl = i < 2 ? sa[2 * i] : sb[2 * i - 4], sh = i < 2 ? sa[2 * i + 1] : sb[2 * i - 3];
            w1[i] = cvt_pk_bf16((x1l * cl - x2l * sl) * qscale, (x1h * ch - x2h * sh) * qscale);
            w2[i] = cvt_pk_bf16((x1l * sl + x2l * cl) * qscale, (x1h * sh + x2h * ch) * qscale);
        }
        qf[4] = __builtin_bit_cast(bf16x8, w1); qf[5] = __builtin_bit_cast(bf16x8, w2);
    }
    if (MODE == 1) { LAS float* bl = (LAS float*)(lds + BIAS_OFF);
        for (int idx = tid; idx < 15 * 128; idx += 512) { const int ro = idx >> 7, cc = idx & 127; bl[idx] = (cc >= 48 && cc < 79) ? rpb_h[ro * 31 + cc - 48] * LOG2E : 0.f; } }
    const int skey = tid >> 3, sch = tid & 7;
    const bf16_t* vbase = Vt + (size_t)(b * DM + h * 64 + skey) * NKEY + sch * 8;
    u32x4 kreg0, rreg0, vreg0, kreg1, rreg1, vreg1;
    rreg0.x = 0u; asm volatile("" : "+v"(rreg0.x)); rreg0.y = rreg0.x; rreg0.z = rreg0.x; rreg0.w = rreg0.x; rreg1 = rreg0;
#define TILE_KB(j) (MODE == 0 ? 64 * (j) : (MODE == 1 ? ((j) < nb ? (R0 + (j)) * 64 : SEQ + ((j) - nb) * 64) : SEQ + 64 * (j)))
#define GLD16(dst, ptr) asm volatile("global_load_dwordx4 %0, %1, off" : "=&v"(dst) : "v"(ptr) : "memory")
#define WAIT_VM0() asm volatile("s_waitcnt vmcnt(0)" ::: "memory")
#define GLOAD(j, S) do { if ((j) < T) { const int kb_ = TILE_KB(j), tk_ = key_tok(b, kb_); \
        GLD16(kreg##S, Kn + (size_t)(tk_ + skey) * 1024 + h * 64 + sch * 8); \
        if (MODE == 0) GLD16(rreg##S, Kr + (size_t)(tk_ + ((tid & 255) >> 2)) * 32 + (tid & 3) * 8); \
        GLD16(vreg##S, vbase + kb_); } } while (0)
#define LSTORE(j, S) do { if ((j) < T) { LAS unsigned char* bp_ = lds + ((((j) >> 1) & 1) * 2 + ((j) & 1)) * BUFB; \
        *(LAS u32x4*)(bp_ + skey * KP + sch * 16) = kreg##S; \
        if (MODE == 0) { if (tid < 256) *(LAS u32x4*)(bp_ + (tid >> 2) * KP + 128 + (tid & 3) * 16) = rreg##S; } \
        *(LAS u32x4*)(bp_ + KBYTES + skey * VP + sch * 16) = vreg##S; } } while (0)
#define BAR_LDS() do { asm volatile("s_waitcnt lgkmcnt(0)" ::: "memory"); __builtin_amdgcn_s_barrier(); asm volatile("" ::: "memory"); } while (0)
    GLOAD(0, 0); GLOAD(1, 1); WAIT_VM0(); LSTORE(0, 0); LSTORE(1, 1); GLOAD(2, 0); GLOAD(3, 1);
    BAR_LDS();
    f32x16 o[2];
#pragma unroll
    for (int i = 0; i < 16; ++i) { o[0][i] = 0.f; o[1][i] = 0.f; }
    float m_ref = 0.f, lsum = 0.f; bool started = false;
    f32x16 negm;
#pragma unroll
    for (int i = 0; i < 16; ++i) negm[i] = 0.f;
    const int prow = (l32 & ~12) | ((l32 & 4) << 1) | ((l32 & 8) >> 1);
#define ATT_TILE(j) do { if ((j) < T) { \
        bool band_ = false, active_ = true; int rr_ = 0; \
        if (MODE == 1 && (j) < nb) { band_ = true; rr_ = R0 + (j); active_ = (rr_ >= r0w) && (rr_ < r0w + 8); } \
        if (active_) attn_tile<MODE>(lds + ((((j) >> 1) & 1) * 2 + ((j) & 1)) * BUFB, lds, qf, o, negm, m_ref, lsum, started, band_, rr_, qrow, qc, c0, prow, l32, hi); } } while (0)
    for (int j = 0; j < T; j += 2) {
        ATT_TILE(j); ATT_TILE(j + 1);
        WAIT_VM0(); LSTORE(j + 2, 0); LSTORE(j + 3, 1);
        GLOAD(j + 4, 0); GLOAD(j + 5, 1);
        BAR_LDS();
    }
#undef ATT_TILE
#undef TILE_KB
#undef GLOAD
#undef LSTORE
#undef GLD16
#undef WAIT_VM0
#undef BAR_LDS
    const float ltot = xor32_sum(lsum), inv = 1.0f / ltot;
    bf16_t* orow = O + (size_t)(q0 + l32) * 1024 + h * 64 + 4 * hi;
#pragma unroll
    for (int dh = 0; dh < 2; ++dh)
#pragma unroll
        for (int g4 = 0; g4 < 4; ++g4) { u32x2 w; w.x = cvt_pk_bf16(o[dh][4 * g4] * inv, o[dh][4 * g4 + 1] * inv); w.y = cvt_pk_bf16(o[dh][4 * g4 + 2] * inv, o[dh][4 * g4 + 3] * inv);
            *(u32x2*)(orow + 32 * dh + 8 * g4) = w; }
}

#define XB_TMO      128
#define XB_XCNT(j)  (256  + 64 * (j))
#define XB_XSUB(j)  (1280 + 64 * (j))
#define XB_XGEN(j)  (2304 + 64 * (j))
#define XB_TOP      3328
#define XB_TOPGEN   3392
#define XCD_BAR_WORDS 3456
#define XB_SPIN_CAP (1u << 18)

__device__ __forceinline__ unsigned xb_ld(unsigned* p)              { return __hip_atomic_load(p, __ATOMIC_RELAXED, __HIP_MEMORY_SCOPE_AGENT); }
__device__ __forceinline__ unsigned xb_add(unsigned* p, unsigned v) { return __hip_atomic_fetch_add(p, v, __ATOMIC_RELAXED, __HIP_MEMORY_SCOPE_AGENT); }
__device__ __forceinline__ unsigned xb_xcc_id() { return (unsigned)__builtin_amdgcn_s_getreg((3 << 11) | 20) & 0xFu; }
#define XB_SPIN(cond, bar) do { unsigned _sp = 0; while (cond) { __builtin_amdgcn_s_sleep(1); \
    if ((++_sp & 255u) == 0u) { if (xb_ld(&(bar)[XB_TMO])) break; if (_sp > XB_SPIN_CAP) { atomicAdd(&(bar)[XB_TMO], 1u); break; } } } } while (0)

struct XcdBarrier {
    unsigned* bar; unsigned x;
    volatile LAS unsigned* st;
};

__device__ __forceinline__ XcdBarrier xcd_barrier_post(unsigned* bar, volatile LAS unsigned* st) {
    XcdBarrier b; b.bar = bar; b.x = xb_xcc_id(); b.st = st;
    if (threadIdx.x == 0) (void)xb_add(&bar[XB_XCNT(b.x)], 1u);
    return b;
}
__device__ __forceinline__ void xcd_barrier_complete(unsigned* bar, unsigned x, unsigned& nloc, unsigned& nx) {
    const unsigned G = gridDim.x * gridDim.y * gridDim.z;
    unsigned sum, cnt, mine, sp = 0u;
    for (;;) {
        sum = 0u; cnt = 0u; mine = 0u;
#pragma unroll
        for (unsigned j = 0; j < 16; ++j) { const unsigned c = xb_ld(&bar[XB_XCNT(j)]); sum += c; cnt += (c > 0u) ? 1u : 0u; mine = (j == x) ? c : mine; }
        if (sum == G) break;
        __builtin_amdgcn_s_sleep(1);
        if ((++sp & 255u) == 0u) { if (xb_ld(&bar[XB_TMO])) break; if (sp > XB_SPIN_CAP) { atomicAdd(&bar[XB_TMO], 1u); break; } }
    }
    nloc = mine > 0u ? mine : 1u; nx = cnt > 0u ? cnt : 1u;
}

__device__ __forceinline__ void xcd_barrier(const XcdBarrier& b) {
    asm volatile("s_waitcnt vmcnt(0)" ::: "memory");
    __syncthreads();
    if (threadIdx.x == 0) {
        unsigned* bar = b.bar;
        __builtin_amdgcn_s_waitcnt(0);
        unsigned nloc = b.st[0], nx = b.st[1];
        if (nloc == 0u) { xcd_barrier_complete(bar, b.x, nloc, nx); b.st[0] = nloc; b.st[1] = nx; }
        const unsigned old = xb_add(&bar[XB_XSUB(b.x)], 1u);
        const unsigned gen = old / nloc;
        if (old + 1u == (gen + 1u) * nloc) {
            __builtin_amdgcn_fence(__ATOMIC_RELEASE, "agent");
            asm volatile("s_waitcnt vmcnt(0)" ::: "memory");
            const unsigned og = xb_add(&bar[XB_TOP], 1u);
            const unsigned tg = og / nx;
            if (og + 1u == (tg + 1u) * nx) xb_add(&bar[XB_TOPGEN], 1u);
            else XB_SPIN(xb_ld(&bar[XB_TOPGEN]) == tg, bar);
            __builtin_amdgcn_fence(__ATOMIC_ACQUIRE, "agent");
            xb_add(&bar[XB_XGEN(b.x)], 1u);
            asm volatile("s_waitcnt vmcnt(0)" ::: "memory");
        } else {
            XB_SPIN(xb_ld(&bar[XB_XGEN(b.x)]) == gen, bar);
            __builtin_amdgcn_fence(__ATOMIC_ACQUIRE, "agent");
            asm volatile("s_waitcnt vmcnt(0)" ::: "memory");
        }
    }
    __syncthreads();
}

#ifndef FUSE_FFN_NORM
#define FUSE_FFN_NORM 0
#endif
constexpr int NPHASES = 38;
constexpr int LDS_BYTES = 147456, MISC_OFF = 131072 + 320;
constexpr size_t WS_CTL = 512 * 1024, CTL_BYTES = 16384;
__host__ __device__ __forceinline__ bool phase_empty(int ph) {
    if (ph == 0 || ph == NPHASES - 1) return false;
    const int L = (ph - 1) / 9, lp = (ph - 1) % 9;
    if (lp == 2) return !(L == 0 || L == 2);
    if (lp == 3) return !(L == 2 || L == 3);
    if (lp == 4) return L == 0;
    if (lp == 6) return FUSE_FFN_NORM && L >= 2;
    return false;
}

#ifndef PROBE_PH
#define PROBE_PH (-1)
#define PROBE_REPS 1
#endif
#ifndef PROBE_BAR_ONLY
#define PROBE_BAR_ONLY 0
#endif
template <bool COOP>
__global__ void __launch_bounds__(512, 2) fwd_kernel(Params p) {
    extern __shared__ __attribute__((aligned(16))) unsigned char lds_raw[];
    LAS unsigned char* lds = (LAS unsigned char*)lds_raw;
    const int tid0 = threadIdx.x;
    volatile LAS unsigned* MISC = (volatile LAS unsigned*)(lds + MISC_OFF);
    if (tid0 < 32) MISC[tid0] = 0u;
    __syncthreads();
    XcdBarrier bar; bar.bar = nullptr; bar.x = 0; bar.st = nullptr;
    if (COOP) bar = xcd_barrier_post((unsigned*)(p.ws + WS_CTL), MISC + 8);

    for (int ph = p.ph_lo; ph < p.ph_hi; ++ph) {
        if (phase_empty(ph)) continue;
        for (int rep = 0; rep < ((ph == PROBE_PH) ? PROBE_REPS : 1); ++rep) {
        if (rep > 0) { if (COOP) xcd_barrier(bar); if (PROBE_BAR_ONLY) continue; }
        int tid = tid0; asm volatile("" : "+v"(tid));
        size_t wsoff = 0; asm volatile("" : "+s"(wsoff)); unsigned char* ws = p.ws + wsoff;
        int G = gridDim.x, bid = blockIdx.x; asm volatile("" : "+s"(G), "+s"(bid));
        const int vcu = (G % 8 == 0) ? (bid % 8) * (G / 8) + bid / 8 : bid;
        const int lane = tid & 63, wid = __builtin_amdgcn_readfirstlane(tid >> 6);
        const int gw = bid * 8 + wid, NGW = G * 8;
        float* MOD = (float*)(ws + WS_MOD);
        const float* cosT = (const float*)(ws + WS_ROPE); const float* sinT = cosT + 4096 * 16;
        bf16_t* H = (bf16_t*)(ws + WS_H);
        bf16_t* BIG = (bf16_t*)(ws + WS_BIG);
        bf16_t* BIG1 = (bf16_t*)(ws + WS_BIG + SUB);
        bf16_t* BIG2 = (bf16_t*)(ws + WS_BIG + 2 * SUB);
        bf16_t* ZG = (bf16_t*)(ws + WS_ZG);
        bf16_t* CQN = ZG; bf16_t* CKVN = (bf16_t*)(ws + WS_ZG + 9 * MiB); bf16_t* QR = (bf16_t*)(ws + WS_ZG + 18 * MiB);
        bf16_t* VT = (bf16_t*)(ws + WS_VT);
        bf16_t* KR = (bf16_t*)(ws + WS_KR);
        float* XC = (float*)(ws + WS_XC);
        if (ph == 0) {
#ifndef NO_PREP
            prep_phase(p, ws, lds, G, bid, tid, wid, lane);
#endif
        }
        else if (ph == NPHASES - 1) final_norm_phase(p.out, p.in[I_FINAL_G], gw, NGW, lane);
        else {
            const int L = (ph - 1) / 9, lp = (ph - 1) % 9;
            const float* modL = MOD + L * 5 * 6144;
            const float* srcL = L == 0 ? p.in[I_X] : p.out; const float* srcC = L == 0 ? p.in[I_CTX] : XC;
            const int nMf = L < 2 ? MT / 256 : ML / 256;
            bf16_t* HN = (FUSE_FFN_NORM && (L == 1 || L == 2)) ? ZG : H;
            if (FUSE_FFN_NORM && lp == 0 && L == 0) shw_phase(MOD, ws, (float*)(ws + WS_SHW), gw, NGW, lane);
            if (lp == 0) norm_phase(srcL, srcC, L < 3 ? MT : ML, p.in[I_MIXG] + L * DM, modL, 0, 1024, H, (const float*)ZG, (L == 1 || L == 2) ? 11 : 0, modL - 5 * 6144 + 4 * 6144 + 5120, XC, L == 3, 0, gw, NGW, lane);
            else if (lp == 6) norm_phase(p.out, XC, L < 2 ? MT : ML, p.in[I_FFNG] + L * DM, modL, 3072, 4096, HN, (const float*)VT, L < 2 ? 4 : 0, modL + 4 * 6144 + 2048, XC, 0, FUSE_FFN_NORM ? ML : 0, gw, NGW, lane);
            else if (lp == 2) {
                if (L == 0) conv_phase(BIG, BIG1, p.in[I_CONV_W], ZG, gw, NGW, lane);
                else mla_thin_phase(BIG2, p.in[I_MLA_QG], p.in[I_MLA_KVG], cosT, sinT, CQN, CKVN, KR, gw, NGW, lane);
            } else if (lp == 4 && L != 3) {
#ifndef NO_ATT
                if (L == 1) {
                    for (int u = vcu; u < 1024 + 64; u += G) {
                        if (u < 1024) { const int bh = u >> 4; attn_unit<1>(lds, bh >> 4, bh & 15, u & 15, BIG, nullptr, BIG1, nullptr, VT, H, p.in[I_NAT_RPB] + (bh & 15) * 15 * 31, nullptr, nullptr, 1.f, tid, wid, lane); }
                        else { const int bh = u - 1024; attn_unit<2>(lds, bh >> 4, bh & 15, 0, BIG, nullptr, BIG1, nullptr, VT, H, nullptr, nullptr, nullptr, 1.f, tid, wid, lane); }
                    }
                } else {
                    for (int u = vcu; u < 1024; u += G) { const int bh = u >> 4; attn_unit<0>(lds, bh >> 4, bh & 15, u & 15, BIG, QR, BIG1, KR, VT, H, nullptr, cosT, sinT, 0.10206207261596575f * LOG2E, tid, wid, lane); }
                }
#endif
            } else if (lp == 5 || lp == 8) {
                for (int job = 0; job < (L < 2 ? 2 : 1); ++job) {
                    pg8::Gemm g; pg8::ResidEpi E; pg8::Order S;
                    E.dstL = p.out; E.dstC = XC; E.srcC = XC; E.rbase = job ? ML : 0; E.atomic = job; E.part = (float*)(lp == 5 ? VT : ZG);
                    E.fuse = FUSE_FFN_NORM && (lp == 5 && job == 0); E.Hn = HN; E.g2 = p.in[I_FFNG] + L * DM; E.sc2 = modL + 4096; E.rowss = (float*)(ws + WS_ROWSS) + L * ML;
                    if (lp == 5) {
                        g.A = ((L == 0 || L == 3) ? ZG : H) + (job ? (size_t)ML * 1024 : 0); g.lda = 1024; g.ldb = 1024; g.K = job ? 256 : 1024;
                        g.Bt = (const bf16_t*)(ws + (L == 0 ? WS_CONV_OUT : L == 1 ? WS_NAT_O : L == 2 ? WS_MLA_O : WS_FNET_O));
                        E.srcL = srcL; E.gate = modL + 2048;
                        if (job) S.init(4, 4, 4, G, bid); else S.init(ML / 256, 4, 1, G, bid);
                    } else {
                        g.A = BIG + (job ? (size_t)ML * FH : 0); g.lda = FH; g.ldb = FH; g.K = job ? 256 : FH; g.Bt = (const bf16_t*)(ws + WS_FFN_OUT + L * FFN_OUT_STRIDE);
                        E.srcL = p.out; E.gate = modL + 5120;
                        if (job) S.init(4, 4, 11, G, bid); else S.init(ML / 256, 4, 1, G, bid);
                    }
                    g.zsA = job ? 512 : 0; g.zsB = job ? 512 : 0;
#ifndef NO_RESID
                    pg8::gemm_phase<pg8::ResidEpi, pg8::Order, true, true>(lds, g, S, E, tid);
#endif
                }
            } else if (lp == 7 || (lp == 1 && L == 0)) {
                pg8::Gemm g; pg8::PairEpi E; pg8::Order S;
                g.A = (lp == 7) ? HN : H; g.lda = 1024; g.ldb = 1024; g.K = 1024; g.zsA = 0; g.zsB = 0;
                E.fuse = FUSE_FFN_NORM && (lp == 7); E.rowss = (const float*)(ws + WS_ROWSS) + L * ML; E.shw = (const float*)(ws + WS_SHW) + (size_t)L * 6 * (2 * FH);
                if (lp == 7) { g.Bt = (const bf16_t*)(ws + WS_FFN_IN + L * FFN_IN_STRIDE); E.act = 1; E.pn0 = 0; E.O0 = BIG; E.ld0 = FH; E.O1 = BIG; E.ld1 = FH; S.init(nMf, 22, 1, G, bid); }
                else { g.Bt = (const bf16_t*)(ws + WS_CONV_IN); E.act = 0; E.pn0 = 4; E.O0 = BIG; E.ld0 = 1024; E.O1 = BIG1; E.ld1 = 1024; S.init(MT / 256, 12, 1, G, bid); }
                #ifndef NO_PAIR
                pg8::gemm_phase<pg8::PairEpi, pg8::Order, true, true>(lds, g, S, E, tid);
#endif
            } else {
                const int njobs = (lp == 1) ? (L == 1 ? 3 : 1) : (L == 2 ? 4 : 1);
                for (int job = 0; job < njobs; ++job) {
                    pg8::Gemm g; pg8::StoreEpi E; pg8::Order S;
                    g.zsA = 0; g.zsB = 0; E.mode = 0; E.s0 = 1.f; E.O1 = nullptr; E.ld1 = 0; E.zrows = 0; E.split = 1 << 30; E.ld0 = 1024; E.coff = 0;
                    if (lp == 1 && L == 1) {
                        g.lda = 1024; g.ldb = 1024; g.K = 1024;
                        const bool cx = job == 2;
                        const bool vjob = job == 1 || (cx && bid >= 32);
                        const size_t ro = cx ? (size_t)ML * 1024 : 0;
                        if (!vjob) { g.A = H + ro; g.Bt = (const bf16_t*)(ws + WS_NAT_QK); E.O0 = BIG + ro; E.s0 = 0.125f * LOG2E; E.split = 1024; E.O1 = BIG1 + ro; E.ld1 = 1024;
                            if (cx) S.init(4, 8, 1, 32, bid); else S.init(ML / 256, 8, 1, G, bid); }
                        else { g.A = (const bf16_t*)(ws + WS_NAT_V); g.Bt = H + ro; E.mode = 1; E.O0 = VT; E.coff = cx ? ML : 0;
                            if (cx) S.init(bid < 48 ? 4 : 0, 4, 1, 16, bid - 32); else S.init(4, ML / 256, 1, G, bid); }
                    }
                    else if (lp == 1 && L == 2) { g.A = H; g.Bt = (const bf16_t*)(ws + WS_MLA_A); g.lda = 1024; g.ldb = 1024; g.K = 1024; E.O0 = BIG2; E.ld0 = 768; S.init(MT / 256, 3, 1, G, bid); }
                    else if (lp == 1) { g.A = (const bf16_t*)(ws + WS_DFTA); g.Bt = H; g.lda = 256; g.ldb = 1024; g.K = 256; g.zsB = 512; E.mode = 2; E.O0 = BIG; S.init(2, ML / 256, 4, G, bid); }
                    else if (L == 2 && (job == 0 || (job == 3 && bid < 144))) { const bool cx = job == 3; const size_t ro = cx ? (size_t)ML : 0;
                        g.A = CKVN + ro * 256; g.Bt = (const bf16_t*)(ws + WS_MLA_K); g.lda = 256; g.ldb = 256; g.K = 256; E.O0 = BIG1 + ro * 1024;
                        if (cx) S.init(bid >= 128 ? 4 : 0, 4, 1, 16, bid - 128); else S.init(ML / 256, 4, 1, G, bid); }
                    else if (L == 2 && job == 2) { g.A = CQN; g.Bt = (const bf16_t*)(ws + WS_MLA_UQ); g.lda = 256; g.ldb = 256; g.K = 256;
                        E.O0 = BIG; E.s0 = 0.10206207261596575f * LOG2E; E.split = 1024; E.O1 = QR; E.ld1 = 512; S.init(ML / 256, 6, 1, G, bid); }
                    else if (L == 2) { const bool cx = job == 3; const size_t ro = cx ? (size_t)ML : 0;
                        g.A = (const bf16_t*)(ws + WS_MLA_V); g.Bt = CKVN + ro * 256; g.lda = 256; g.ldb = 256; g.K = 256; E.mode = 1; E.O0 = VT; E.coff = cx ? ML : 0;
                        if (cx) S.init(bid < 160 ? 4 : 0, 4, 1, 16, bid - 144); else S.init(4, ML / 256, 1, G, bid); }
                    else if (lp == 3) { g.A = (const bf16_t*)(ws + WS_DFTA) + 512 * 256; g.Bt = BIG; g.lda = 256; g.ldb = 256; g.K = 256; E.mode = 3; E.O0 = (bf16_t*)(ws + WS_DFTB); S.init(1, 512, 1, G, bid); }
                    else { g.A = (const bf16_t*)(ws + WS_DFTA) + 768 * 256; g.Bt = (const bf16_t*)(ws + WS_DFTB); g.lda = 256; g.ldb = 256; g.K = 256; E.mode = 4; E.O0 = ZG; S.init(1, 512, 1, G, bid); }
                    #ifndef NO_STORE
                    pg8::gemm_phase<pg8::StoreEpi, pg8::Order, true, true>(lds, g, S, E, tid);
#endif
                }
            }
        }
        }
        if (COOP) { if (ph + 1 < p.ph_hi) { if (ph == 0) cg::this_grid().sync(); else xcd_barrier(bar); } }
    }
}

#ifndef MK_MULTI
#define MK_MULTI 0
#endif
extern "C" void kernel_launch(void* const* d_in, const int* in_sizes, int n_in, void* d_out, int out_size, void* d_ws, size_t ws_size, hipStream_t stream) {
    static int grid = 0;
    if (grid == 0) {
        if (n_in != 25 || out_size != ML * DM || ws_size < WS_END) { fprintf(stderr, "kernel_launch: unexpected problem: n_in %d out %d ws %zu (need %zu)\n", n_in, out_size, ws_size, (size_t)WS_END); grid = -1; return; }
        int dev = 0, cus = 0, per_cu = 0;
        (void)hipGetDevice(&dev); (void)hipDeviceGetAttribute(&cus, hipDeviceAttributeMultiprocessorCount, dev);
        (void)hipFuncSetAttribute((const void*)fwd_kernel<true>, hipFuncAttributeMaxDynamicSharedMemorySize, LDS_BYTES);
        (void)hipFuncSetAttribute((const void*)fwd_kernel<false>, hipFuncAttributeMaxDynamicSharedMemorySize, LDS_BYTES);
        (void)hipOccupancyMaxActiveBlocksPerMultiprocessor(&per_cu, (const void*)fwd_kernel<true>, 512, LDS_BYTES);
        if (per_cu < 1) { fprintf(stderr, "kernel_launch: occupancy query says %d blocks per CU\n", per_cu); per_cu = 1; }
        (void)hipGetLastError();
        grid = cus;
        if (grid <= 0) grid = 256;
    }
    if (grid < 0) return;
    Params p{};
    for (int i = 0; i < 25; ++i) p.in[i] = (const float*)d_in[i];
    p.out = (float*)d_out; p.ws = (unsigned char*)d_ws;
#if MK_MULTI
    for (int ph = 0; ph < NPHASES; ++ph) {
        if (phase_empty(ph)) continue;
        p.ph_lo = ph; p.ph_hi = ph + 1;
        hipLaunchKernelGGL(fwd_kernel<false>, dim3(grid), dim3(512), LDS_BYTES, stream, p);
    }
#else
    p.ph_lo = 0; p.ph_hi = NPHASES;
    (void)hipMemsetAsync((char*)d_ws + WS_CTL, 0, CTL_BYTES, stream);
    void* args[] = {&p};
    hipError_t e = hipLaunchCooperativeKernel((const void*)fwd_kernel<true>, dim3(grid), dim3(512), args, LDS_BYTES, stream);
    if (e != hipSuccess) fprintf(stderr, "cooperative launch failed: %s (grid %d)\n", hipGetErrorString(e), grid);
#endif
}
```

```cpp
#include <hip/hip_runtime.h>
#include <hip/hip_cooperative_groups.h>
#include <cstdio>
#include <cstdint>
namespace cg = cooperative_groups;

#define LAS __attribute__((address_space(3)))
typedef unsigned short bf16_t;
typedef short bf16x8 __attribute__((ext_vector_type(8)));
typedef float f32x4 __attribute__((ext_vector_type(4)));
typedef float f32x2 __attribute__((ext_vector_type(2)));
typedef float f32x16 __attribute__((ext_vector_type(16)));
typedef unsigned u32x4 __attribute__((ext_vector_type(4)));
typedef unsigned u32x2 __attribute__((ext_vector_type(2)));

__device__ __forceinline__ unsigned cvt_pk_bf16(float lo, float hi) { unsigned r; asm("v_cvt_pk_bf16_f32 %0, %1, %2" : "=v"(r) : "v"(lo), "v"(hi)); return r; }
__device__ __forceinline__ float bf_lo(unsigned w) { return __uint_as_float(w << 16); }
__device__ __forceinline__ float bf_hi(unsigned w) { return __uint_as_float(w & 0xffff0000u); }
__device__ __forceinline__ float silu_f(float v) { return v * __builtin_amdgcn_rcpf(1.0f + __expf(-v)); }
__device__ __forceinline__ float xor32_sum(float v) { const auto rr = __builtin_amdgcn_permlane32_swap(__float_as_uint(v), __float_as_uint(v), false, false); return __uint_as_float(rr[0]) + __uint_as_float(rr[1]); }
__device__ __forceinline__ float xor32_max(float v) { const auto rr = __builtin_amdgcn_permlane32_swap(__float_as_uint(v), __float_as_uint(v), false, false); return fmaxf(__uint_as_float(rr[0]), __uint_as_float(rr[1])); }
#define SWZ_XOR(v, k) __int_as_float(__builtin_amdgcn_ds_swizzle(__float_as_int(v), ((k) << 10) | 0x1f))
__device__ __forceinline__ float wave_sum(float v) {
    v += SWZ_XOR(v, 1); v += SWZ_XOR(v, 2); v += SWZ_XOR(v, 4); v += SWZ_XOR(v, 8); v += SWZ_XOR(v, 16);
    return xor32_sum(v);
}

constexpr int DM = 1024, NB = 4, SEQ = 4096, CTXL = 256, FH = 2816;
constexpr int ML = NB * SEQ;
constexpr int MC = NB * CTXL;
constexpr int MT = ML + MC;
constexpr int NKEY = SEQ + CTXL;
constexpr float LOG2E = 1.4426950408889634f;
constexpr float NORM_EPS = 1e-6f;

__device__ __forceinline__ int mod_row(int r) { return r < ML ? (r >> 12) : 4; }
__device__ __forceinline__ void tok_bk(int t, int& b, int& key) { if (t < ML) { b = t >> 12; key = t & 4095; } else { const int c = t - ML; b = c >> 8; key = SEQ + (c & 255); } }
__device__ __forceinline__ int key_tok(int b, int key) { return key < SEQ ? b * SEQ + key : ML + b * CTXL + (key - SEQ); }

namespace pg8 {
#define PG8_LAS __attribute__((address_space(3)))
constexpr int BM = 256, BK = 64, HALF = 128, HTB = HALF * BK * 2, STAGE_BYTES = 8 * HTB, NXCD = 8, WGM = 8;
__host__ __device__ __forceinline__ int lds_byte(int r, int c) { const int st = (r >> 4) * 2 + (c >> 5), rr = r & 15, cc = c & 31, ob = rr * 64 + cc * 2; return st * 1024 + (ob ^ (((ob >> 9) & 1) << 5)); }
__host__ __device__ __forceinline__ void stage_rc(int b, int& R, int& C) { const int st = b / 1024, sb = b % 1024, swz = sb ^ (((sb >> 9) & 1) << 5); R = (st >> 1) * 16 + swz / 64; C = (st & 1) * 32 + (swz % 64) / 2; }
__host__ __device__ __forceinline__ int perm32(int rho) { const int n = rho >> 4, i = rho & 15; return 8 * (i >> 2) + 4 * n + (i & 3); }

struct Unit { int pm, pn, z; };
struct Gemm { const bf16_t* A; const bf16_t* Bt; int lda, ldb, K; size_t zsA, zsB; };
struct Order {
    int nM, nN, nMz, nwg, G, c;
    __device__ __forceinline__ void init(int nM_, int nN_, int nZ, int G_, int c_) { nM = nM_; nN = nN_; nMz = nM_ * nZ; nwg = nMz * nN; G = G_; c = c_; }
    __device__ __forceinline__ bool next(int i, Unit& u) const {
        const long L = (long)i * G + c; if (c < 0 || L >= nwg) return false;
        int wgid = (int)L; { const int q = nwg / NXCD, r = nwg % NXCD, xcd = wgid % NXCD, off = wgid / NXCD; wgid = (xcd < r ? xcd * (q + 1) : r * (q + 1) + (xcd - r) * q) + off; }
        const int nig = WGM * nN, gid = wgid / nig, fm = gid * WGM, gsz = (nMz - fm) < WGM ? (nMz - fm) : WGM;
        const int pmz = fm + ((wgid % nig) % gsz); u.pn = (wgid % nig) / gsz; u.z = pmz / nM; u.pm = pmz % nM; return true;
    }
    __device__ __forceinline__ void a_ready(const Unit&) const {}
    __device__ __forceinline__ void done(const Unit&) const {}
};

struct StoreEpi {
    static constexpr bool PERM = true, AFTER_DRAIN = false, INIT_ACC = false;
    int mode;
    bf16_t* O0; int ld0; float s0; int split; bf16_t* O1; int ld1; int zrows; int coff;
    __device__ __forceinline__ void operator()(const f32x4 (&acc)[2][2][4][2], const Unit& u, int wr, int wc, int fr, int fq) const {
        if (mode >= 3) {
#pragma unroll
            for (int m = 0; m < 4; ++m) {
                int kq = m * 16 + fr;
                asm volatile("" : "+v"(kq) :: "memory");
#pragma unroll
                for (int bj = 0; bj < 2; ++bj) {
                    const int R = u.pn * BM + bj * HALF + wc * 32 + 8 * fq;
                    if (mode == 3) {
                        const int col = R >> 5, n2 = (R & 31) + 32 * wr, b = col >> 10, colb = col & 1023;
                        bf16_t* p = O0 + ((size_t)((b * 32 + (kq & 31)) * 1024 + colb)) * 256 + (kq >> 5) * 128 + n2;
#pragma unroll
                        for (int nn = 0; nn < 2; ++nn) {
                            const f32x4 a = acc[0][bj][m][nn], bb = acc[1][bj][m][nn]; float tr[4], ti[4];
#pragma unroll
                            for (int i = 0; i < 4; ++i) { const float x = (float)((n2 + 4 * nn + i) * kq) * (1.f / 4096.f); const float ct = __builtin_amdgcn_cosf(x), st = __builtin_amdgcn_sinf(x);
                                tr[i] = a[i] * ct + bb[i] * st; ti[i] = bb[i] * ct - a[i] * st; }
                            u32x2 w; w.x = cvt_pk_bf16(tr[0], tr[1]); w.y = cvt_pk_bf16(tr[2], tr[3]); *(u32x2*)(p + 4 * nn) = w;
                            w.x = cvt_pk_bf16(ti[0], ti[1]); w.y = cvt_pk_bf16(ti[2], ti[3]); *(u32x2*)(p + 64 + 4 * nn) = w;
                            asm volatile("" ::: "memory");
                        }
                    } else {
                        const int b = R >> 15, k1lo = (R >> 10) & 31, colb = R & 1023;
                        const f32x4 v0 = acc[0][bj][m][0], v1 = acc[0][bj][m][1];
                        u32x4 w; w.x = cvt_pk_bf16(v0[0], v0[1]); w.y = cvt_pk_bf16(v0[2], v0[3]); w.z = cvt_pk_bf16(v1[0], v1[1]); w.w = cvt_pk_bf16(v1[2], v1[3]);
                        *(u32x4*)(O0 + (size_t)(b * 4096 + k1lo + 32 * wr + 64 * kq) * 1024 + colb) = w;
                    }
                }
                asm volatile("" ::: "memory");
            }
            return;
        }
#pragma unroll
        for (int ai = 0; ai < 2; ++ai)
#pragma unroll
            for (int m = 0; m < 4; ++m) {
                const int r = u.pm * BM + ai * HALF + wr * 64 + m * 16 + fr;
#pragma unroll
                for (int bj = 0; bj < 2; ++bj) {
                    const int c = u.pn * BM + bj * HALF + wc * 32 + 8 * fq;
                    bf16_t* p; float sc = 1.f;
                    if (mode == 0) { if (c < split) { p = O0 + (size_t)(u.z * zrows + r) * ld0 + c; sc = s0; } else p = O1 + (size_t)r * ld1 + (c - split); }
                    else if (mode == 1) { int b, key; tok_bk(c + coff, b, key); p = O0 + (size_t)(b * DM + r) * NKEY + key; }
                    else { const int ri = r >> 8, k2 = r & 255, b = c >> 12, pp = c & 4095; p = O0 + (size_t)((b * 4 + u.z) * 256 + k2) * 8192 + (pp >> 6) * 128 + ri * 64 + (pp & 63); }
                    const f32x4 v0 = acc[ai][bj][m][0] * sc, v1 = acc[ai][bj][m][1] * sc;
                    u32x4 w; w.x = cvt_pk_bf16(v0[0], v0[1]); w.y = cvt_pk_bf16(v0[2], v0[3]); w.z = cvt_pk_bf16(v1[0], v1[1]); w.w = cvt_pk_bf16(v1[2], v1[3]);
                    *(u32x4*)p = w;
                }
                asm volatile("" ::: "memory");
            }
    }
};
struct PairEpi {
    static constexpr bool PERM = true, AFTER_DRAIN = false, INIT_ACC = false;
    int act;
    int pn0; bf16_t* O0; int ld0; bf16_t* O1; int ld1;
    int fuse; const float* rowss; const float* shw;
    __device__ __forceinline__ void operator()(const f32x4 (&acc)[2][2][4][2], const Unit& u, int wr, int wc, int fr, int fq) const {
        if (u.pn < pn0) {
#pragma unroll
            for (int ai = 0; ai < 2; ++ai)
#pragma unroll
                for (int m = 0; m < 4; ++m) {
                    const int r = u.pm * BM + ai * HALF + wr * 64 + m * 16 + fr;
#pragma unroll
                    for (int bj = 0; bj < 2; ++bj) {
                        const int c = u.pn * BM + bj * HALF + wc * 32 + 8 * fq;
                        const f32x4 v0 = acc[ai][bj][m][0], v1 = acc[ai][bj][m][1];
                        u32x4 w; w.x = cvt_pk_bf16(v0[0], v0[1]); w.y = cvt_pk_bf16(v0[2], v0[3]); w.z = cvt_pk_bf16(v1[0], v1[1]); w.w = cvt_pk_bf16(v1[2], v1[3]);
                        *(u32x4*)(O0 + (size_t)r * ld0 + c) = w;
                    }
                    asm volatile("" ::: "memory");
                }
        } else {
            const int c = (u.pn - pn0) * HALF + wc * 32 + 8 * fq;
            f32x4 shg[2], shu[2];
            if (fuse) { const int r0 = u.pm * BM; const float* sp = shw + (r0 < ML ? (r0 >> 12) : 5) * (2 * FH) + u.pn * BM + wc * 32 + 8 * fq;
                shg[0] = *(const f32x4*)sp; shg[1] = *(const f32x4*)(sp + 4); shu[0] = *(const f32x4*)(sp + HALF); shu[1] = *(const f32x4*)(sp + HALF + 4); }
            float rsv[2][4];
#pragma unroll
            for (int ai = 0; ai < 2; ++ai)
#pragma unroll
                for (int m = 0; m < 4; ++m) { const int r = u.pm * BM + ai * HALF + wr * 64 + m * 16 + fr; rsv[ai][m] = (fuse && r < ML) ? rowss[r] : 0.f; }
#pragma unroll
            for (int ai = 0; ai < 2; ++ai)
#pragma unroll
                for (int m = 0; m < 4; ++m) rsv[ai][m] = (fuse && u.pm * BM < ML) ? rsqrtf(rsv[ai][m] * (1.f / DM) + NORM_EPS) : 1.f;
#pragma unroll
            for (int ai = 0; ai < 2; ++ai)
#pragma unroll
                for (int m = 0; m < 4; ++m) {
                    const int r = u.pm * BM + ai * HALF + wr * 64 + m * 16 + fr;
                    const float rs = rsv[ai][m];
                    f32x4 v[2];
#pragma unroll
                    for (int n = 0; n < 2; ++n) {
                        f32x4 a = acc[ai][0][m][n], b = acc[ai][1][m][n];
                        if (fuse) { a = a * rs + shg[n]; b = b * rs + shu[n]; }
                        if (act == 1) { v[n] = (f32x4){silu_f(a[0]) * b[0], silu_f(a[1]) * b[1], silu_f(a[2]) * b[2], silu_f(a[3]) * b[3]}; }
                        else v[n] = a * b;
                    }
                    u32x4 w; w.x = cvt_pk_bf16(v[0][0], v[0][1]); w.y = cvt_pk_bf16(v[0][2], v[0][3]); w.z = cvt_pk_bf16(v[1][0], v[1][1]); w.w = cvt_pk_bf16(v[1][2], v[1][3]);
                    *(u32x4*)(O1 + (size_t)r * ld1 + c) = w;
                    asm volatile("" ::: "memory");
                }
        }
    }
};
struct ResidEpi {
    static constexpr bool PERM = false, AFTER_DRAIN = false, INIT_ACC = true;
    __device__ __forceinline__ static f32x4 gclamp(f32x4 g) { f32x4 r;
#pragma unroll
        for (int i = 0; i < 4; ++i) r[i] = fabsf(g[i]) < 1e-12f ? 1e-12f : g[i];
        return r; }
    __device__ __forceinline__ void init(f32x4 (&acc)[2][2][4][2], const Unit& u, int wr, int wc, int fr, int fq, float zf) const {
        if (atomic) {
#pragma unroll
            for (int a = 0; a < 2; ++a)
#pragma unroll
                for (int b = 0; b < 2; ++b)
#pragma unroll
                    for (int m = 0; m < 4; ++m)
#pragma unroll
                        for (int n = 0; n < 2; ++n) acc[a][b][m][n] = (f32x4){zf, zf, zf, zf};
            return;
        }
        const int mr = mod_row(rbase + u.pm * BM);
#pragma unroll
        for (int ai = 0; ai < 2; ++ai)
#pragma unroll
            for (int m = 0; m < 4; ++m) { const int r = rbase + u.pm * BM + ai * HALF + wr * 64 + m * 16 + fr;
                const float* s = r < ML ? srcL + (size_t)r * DM : srcC + (size_t)(r - ML) * DM;
#pragma unroll
                for (int bj = 0; bj < 2; ++bj)
#pragma unroll
                    for (int n = 0; n < 2; ++n) acc[ai][bj][m][n] = *(const f32x4*)(s + u.pn * BM + bj * HALF + wc * 32 + 16 * n + 4 * fq); }
#pragma unroll
        for (int bj = 0; bj < 2; ++bj)
#pragma unroll
            for (int n = 0; n < 2; ++n) { const f32x4 gc = gclamp(*(const f32x4*)(gate + mr * 6144 + u.pn * BM + bj * HALF + wc * 32 + 16 * n + 4 * fq));
                const f32x4 gi = (f32x4){1.0f / gc[0], 1.0f / gc[1], 1.0f / gc[2], 1.0f / gc[3]};
#pragma unroll
                for (int ai = 0; ai < 2; ++ai)
#pragma unroll
                    for (int m = 0; m < 4; ++m) acc[ai][bj][m][n] *= gi; }
    }
    const float* srcL; const float* srcC; float* dstL; float* dstC; const float* gate;
    int rbase, atomic; float* part;
    int fuse; bf16_t* Hn; const float* g2; const float* sc2; float* rowss;
    __device__ __forceinline__ void operator()(const f32x4 (&acc)[2][2][4][2], const Unit& u, int wr, int wc, int fr, int fq) const {
        const int mr = mod_row(rbase + u.pm * BM);
        f32x4 gv[2][2], gm[2][2];
#pragma unroll
        for (int bj = 0; bj < 2; ++bj)
#pragma unroll
            for (int n = 0; n < 2; ++n) { const int c = u.pn * BM + bj * HALF + wc * 32 + 16 * n + 4 * fq;
                gv[bj][n] = gclamp(*(const f32x4*)(gate + mr * 6144 + c));
                gm[bj][n] = fuse ? *(const f32x4*)(g2 + c) * (*(const f32x4*)(sc2 + mr * 6144 + c) + 1.0f) : gv[bj][n]; }
#pragma unroll
        for (int ai = 0; ai < 2; ++ai)
#pragma unroll
            for (int m = 0; m < 4; ++m) {
                const int r = rbase + u.pm * BM + ai * HALF + wr * 64 + m * 16 + fr;
                const float* s = r < ML ? srcL + (size_t)r * DM : srcC + (size_t)(r - ML) * DM;
                float* d = r < ML ? dstL + (size_t)r * DM : dstC + (size_t)(r - ML) * DM;
                float ss = 0.f;
#pragma unroll
                for (int bj = 0; bj < 2; ++bj)
#pragma unroll
                    for (int n = 0; n < 2; ++n) {
                        const int c = u.pn * BM + bj * HALF + wc * 32 + 16 * n + 4 * fq;
                        if (atomic) { *(f32x4*)(part + ((size_t)(u.z * MC + (r - ML)) * DM + c)) = acc[ai][bj][m][n]; }
                        else {
                            const f32x4 xn = gv[bj][n] * acc[ai][bj][m][n]; *(f32x4*)(d + c) = xn;
                            if (fuse) { ss += (xn[0] * xn[0] + xn[1] * xn[1]) + (xn[2] * xn[2] + xn[3] * xn[3]); const f32x4 xg = xn * gm[bj][n];
                                u32x2 w; w.x = cvt_pk_bf16(xg[0], xg[1]); w.y = cvt_pk_bf16(xg[2], xg[3]); *(u32x2*)(Hn + (size_t)r * DM + c) = w; }
                        }
                    }
                if (fuse) { ss += SWZ_XOR(ss, 16); ss = xor32_sum(ss); if (fq == 0) unsafeAtomicAdd(rowss + r, ss); }
                if (fuse && (m & 1)) asm volatile("" ::: "memory");
            }
    }
};

template <class Epi, class Sched, bool ALIGN_EPI = false, bool SP2 = false>
__device__ __forceinline__ void gemm_phase(PG8_LAS unsigned char* lds, const Gemm g, const Sched& S, const Epi& E, const int tid) {
    const int wid = __builtin_amdgcn_readfirstlane(tid >> 6), lane = tid & 63, wr = wid >> 2, wc = wid & 3, fr = lane & 15, fq = lane >> 4;
    const int K = g.K, nt = K / BK, lda = g.lda, ldb = g.ldb;
    unsigned voffA[2], voffB[2];
#pragma unroll
    for (int i = 0; i < 2; ++i) { int R, C; stage_rc(tid * 16 + i * 8192, R, C); const int Rb = Epi::PERM ? ((R & ~31) + perm32(R & 31)) : R;
        voffA[i] = (unsigned)(R * lda + C) * 2u; voffB[i] = (unsigned)(Rb * ldb + C) * 2u; }
    const size_t kstep = (size_t)(BK * 2);
    const size_t hstepA = (size_t)HALF * lda * 2, hstepB = (size_t)HALF * ldb * 2;
    const size_t tstepA = 2 * hstepA, tstepB = 2 * hstepB;
    const unsigned ldsw = (unsigned)wid * 1024u;
    const int aoff = lds_byte(wr * 64 + fr, fq * 8), boff = lds_byte(wc * 32 + fr, fq * 8);
#define PG8_SA(b, h) (((b) * 2 + (h)) * HTB)
#define PG8_SB(b, h) ((4 + (b) * 2 + (h)) * HTB)
#define PG8_STAGE(bufoff, gbase, voff) do { _Pragma("unroll") for (int _i = 0; _i < 2; ++_i) \
        __builtin_amdgcn_global_load_lds((const unsigned*)((const char*)(gbase) + (voff)[_i]), (PG8_LAS unsigned*)(lds + (bufoff) + ldsw + _i * 8192), 16, 0, 0); } while (0)
#define PG8_LDA(dst, b, h) do { _Pragma("unroll") for (int m = 0; m < 4; ++m) _Pragma("unroll") for (int k = 0; k < 2; ++k) dst[m][k] = *(const PG8_LAS bf16x8*)(lds + PG8_SA(b, h) + aoff + m * 2048 + k * 1024); } while (0)
#define PG8_LDB(dst, b, h) do { _Pragma("unroll") for (int n = 0; n < 2; ++n) _Pragma("unroll") for (int k = 0; k < 2; ++k) dst[n][k] = *(const PG8_LAS bf16x8*)(lds + PG8_SB(b, h) + boff + n * 2048 + k * 1024); } while (0)
#define PG8_MMA(ai, bj, At, Bt) do { __builtin_amdgcn_s_setprio(1); _Pragma("unroll") for (int m = 0; m < 4; ++m) _Pragma("unroll") for (int n = 0; n < 2; ++n) _Pragma("unroll") for (int k = 0; k < 2; ++k) \
        acc[ai][bj][m][n] = __builtin_amdgcn_mfma_f32_16x16x32_bf16(Bt[n][k], At[m][k], acc[ai][bj][m][n], 0, 0, 0); __builtin_amdgcn_s_setprio(0); } while (0)
#define PG8_WAIT_V(n) asm volatile("s_waitcnt vmcnt(" #n ")" ::: "memory")
#define PG8_WAIT_L(n) asm volatile("s_waitcnt lgkmcnt(" #n ")" ::: "memory")
#define PG8_BAR __builtin_amdgcn_s_barrier()
#define PG8_SCHED __builtin_amdgcn_sched_barrier(0)
    Unit cur, nxt; int ui = 0;
    if (!S.next(0, cur)) return;
    float zf_ = 0.f; asm volatile("" : "+v"(zf_));
    f32x4 acc[2][2][4][2];
    if constexpr (Epi::INIT_ACC) E.init(acc, cur, wr, wc, fr, fq, zf_);
    else {
#pragma unroll
    for (int a = 0; a < 2; ++a)
#pragma unroll
        for (int b = 0; b < 2; ++b)
#pragma unroll
            for (int m = 0; m < 4; ++m)
#pragma unroll
                for (int n = 0; n < 2; ++n) acc[a][b][m][n] = (f32x4){zf_, zf_, zf_, zf_};
    }
    bf16x8 At[4][2], B0[2][2], B1[2][2];
    const char* cA = (const char*)g.A + (size_t)cur.z * g.zsA + (size_t)cur.pm * tstepA; const char* cB = (const char*)g.Bt + (size_t)cur.z * g.zsB + (size_t)cur.pn * tstepB;
    S.a_ready(cur);
    if constexpr (SP2) {
        PG8_STAGE(PG8_SB(0, 0), cB, voffB); PG8_STAGE(PG8_SB(0, 1), cB + hstepB, voffB); PG8_STAGE(PG8_SA(0, 0), cA, voffA); PG8_STAGE(PG8_SA(0, 1), cA + hstepA, voffA);
        if (wr == 1) PG8_BAR;
        PG8_WAIT_V(2); PG8_BAR;
        PG8_STAGE(PG8_SB(1, 0), cB + kstep, voffB); PG8_STAGE(PG8_SA(1, 0), cA + kstep, voffA); PG8_STAGE(PG8_SB(1, 1), cB + hstepB + kstep, voffB);
        PG8_WAIT_V(6); PG8_BAR;
    } else {
        PG8_STAGE(PG8_SB(0, 0), cB, voffB); PG8_STAGE(PG8_SA(0, 0), cA, voffA); PG8_STAGE(PG8_SB(0, 1), cB + hstepB, voffB); PG8_STAGE(PG8_SA(0, 1), cA + hstepA, voffA);
        if (wr == 1) PG8_BAR;
        PG8_WAIT_V(4); PG8_BAR;
        PG8_STAGE(PG8_SB(1, 0), cB + kstep, voffB); PG8_STAGE(PG8_SA(1, 0), cA + kstep, voffA); PG8_STAGE(PG8_SB(1, 1), cB + hstepB + kstep, voffB);
        PG8_WAIT_V(6); PG8_BAR;
    }
    for (;;) {
        const bool has_next = S.next(ui + 1, nxt);
        const char* nA = has_next ? (const char*)g.A + (size_t)nxt.z * g.zsA + (size_t)nxt.pm * tstepA : cA; const char* nB = has_next ? (const char*)g.Bt + (size_t)nxt.z * g.zsB + (size_t)nxt.pn * tstepB : cB;
        for (int t = 0; t < nt; t += 2) {
            const bool last = (t == nt - 2);
            const char* a1 = cA + (size_t)(t + 1) * kstep;
            const char* a2 = last ? nA : cA + (size_t)(t + 2) * kstep; const char* b2 = last ? nB : cB + (size_t)(t + 2) * kstep;
            const char* a3 = a2 + kstep; const char* b3 = b2 + kstep;
            if (last && has_next) S.a_ready(nxt);
            if constexpr (SP2) {
            PG8_LDB(B0, 0, 0); PG8_LDB(B1, 0, 1); PG8_SCHED; PG8_LDA(At, 0, 0); PG8_STAGE(PG8_SA(1, 1), a1 + hstepA, voffA);
            PG8_WAIT_V(8); PG8_WAIT_L(0); PG8_BAR; PG8_MMA(0, 0, At, B0); PG8_MMA(0, 1, At, B1); PG8_BAR; PG8_SCHED;
            PG8_LDA(At, 0, 1); PG8_STAGE(PG8_SB(0, 0), b2, voffB); PG8_STAGE(PG8_SB(0, 1), b2 + hstepB, voffB); PG8_STAGE(PG8_SA(0, 0), a2, voffA);
            PG8_WAIT_V(8); PG8_WAIT_L(0); PG8_BAR; PG8_MMA(1, 0, At, B0); PG8_MMA(1, 1, At, B1); PG8_BAR; PG8_SCHED;
            PG8_LDB(B0, 1, 0); PG8_LDB(B1, 1, 1); PG8_SCHED; PG8_LDA(At, 1, 0); PG8_STAGE(PG8_SA(0, 1), a2 + hstepA, voffA);
            PG8_WAIT_V(8); PG8_WAIT_L(0); PG8_BAR; PG8_MMA(0, 0, At, B0); PG8_MMA(0, 1, At, B1); PG8_BAR; PG8_SCHED;
            PG8_LDA(At, 1, 1); PG8_STAGE(PG8_SB(1, 0), b3, voffB); PG8_STAGE(PG8_SB(1, 1), b3 + hstepB, voffB); PG8_STAGE(PG8_SA(1, 0), a3, voffA);
            PG8_WAIT_V(8); PG8_WAIT_L(0); PG8_BAR; PG8_MMA(1, 0, At, B0); PG8_MMA(1, 1, At, B1); PG8_BAR; PG8_SCHED;
            } else {
            PG8_LDB(B0, 0, 0); PG8_SCHED; PG8_LDA(At, 0, 0); PG8_STAGE(PG8_SA(1, 1), a1 + hstepA, voffA);
            PG8_WAIT_L(8); PG8_BAR; PG8_WAIT_L(0); PG8_MMA(0, 0, At, B0); PG8_BAR; PG8_SCHED;
            PG8_LDB(B1, 0, 1); PG8_STAGE(PG8_SB(0, 0), b2, voffB);
            PG8_BAR; PG8_WAIT_L(0); PG8_MMA(0, 1, At, B1); PG8_BAR;
            PG8_LDA(At, 0, 1); PG8_STAGE(PG8_SA(0, 0), a2, voffA);
            PG8_BAR; PG8_WAIT_L(0); PG8_MMA(1, 0, At, B0); PG8_BAR; PG8_SCHED;
            PG8_STAGE(PG8_SB(0, 1), b2 + hstepB, voffB);
            PG8_WAIT_V(6); PG8_BAR; PG8_MMA(1, 1, At, B1); PG8_BAR;
            PG8_LDB(B0, 1, 0); PG8_SCHED; PG8_LDA(At, 1, 0); PG8_STAGE(PG8_SA(0, 1), a2 + hstepA, voffA);
            PG8_WAIT_L(8); PG8_BAR; PG8_WAIT_L(0); PG8_MMA(0, 0, At, B0); PG8_BAR; PG8_SCHED;
            PG8_LDB(B1, 1, 1); PG8_STAGE(PG8_SB(1, 0), b3, voffB);
            PG8_BAR; PG8_WAIT_L(0); PG8_MMA(0, 1, At, B1); PG8_BAR;
            PG8_LDA(At, 1, 1); PG8_STAGE(PG8_SA(1, 0), a3, voffA);
            PG8_BAR; PG8_WAIT_L(0); PG8_MMA(1, 0, At, B0); PG8_BAR; PG8_SCHED;
            PG8_STAGE(PG8_SB(1, 1), b3 + hstepB, voffB);
            PG8_WAIT_V(6); PG8_BAR; PG8_MMA(1, 1, At, B1); PG8_BAR;
            }
        }
        if constexpr (ALIGN_EPI) { if (wr == 0) PG8_BAR; }
        if constexpr (!Epi::AFTER_DRAIN) { E(acc, cur, wr, wc, fr, fq); S.done(cur); }
        if (!has_next) break;
        if constexpr (Epi::INIT_ACC) E.init(acc, nxt, wr, wc, fr, fq, zf_);
        else {
#pragma unroll
        for (int a = 0; a < 2; ++a)
#pragma unroll
            for (int b = 0; b < 2; ++b)
#pragma unroll
                for (int m = 0; m < 4; ++m)
#pragma unroll
                    for (int n = 0; n < 2; ++n) acc[a][b][m][n] = (f32x4){zf_, zf_, zf_, zf_};
        }
        cur = nxt; cA = nA; cB = nB; ++ui;
        if constexpr (ALIGN_EPI) { if (wr == 1) PG8_BAR; }
    }
    PG8_WAIT_V(0);
    if constexpr (!ALIGN_EPI) { if (wr == 0) PG8_BAR; }
    PG8_BAR;
    if constexpr (Epi::AFTER_DRAIN) { E.fused(acc, cur, wr, wc, fr, fq, lds, wid, lane); S.done(cur); }
#undef PG8_SA
#undef PG8_SB
#undef PG8_STAGE
#undef PG8_LDA
#undef PG8_LDB
#undef PG8_MMA
#undef PG8_WAIT_V
#undef PG8_WAIT_L
#undef PG8_BAR
#undef PG8_SCHED
}
}

constexpr size_t MiB = (size_t)1 << 20;
constexpr size_t WS_MOD = 0;
constexpr size_t WS_ROPE = 1 * MiB;
constexpr size_t WS_DFTA = 2 * MiB;
constexpr size_t WS_KR = 3 * MiB;
constexpr size_t WS_XC = 5 * MiB;
constexpr size_t WS_CONV_IN = 9 * MiB, WS_CONV_OUT = 15 * MiB, WS_NAT_QK = 17 * MiB, WS_NAT_V = 21 * MiB, WS_NAT_O = 23 * MiB;
constexpr size_t WS_MLA_A = 25 * MiB, WS_MLA_UQ = 27 * MiB, WS_MLA_K = 28 * MiB, WS_MLA_V = 29 * MiB, WS_MLA_O = 30 * MiB, WS_FNET_O = 32 * MiB;
constexpr size_t WS_FFN_IN = 34 * MiB, FFN_IN_STRIDE = 11 * MiB, WS_FFN_OUT = 78 * MiB, FFN_OUT_STRIDE = (size_t)DM * FH * 2;
constexpr size_t WS_DFTB = 100 * MiB;
constexpr size_t WS_H = 164 * MiB;
constexpr size_t WS_BIG = 198 * MiB;
constexpr size_t WS_ZG = 300 * MiB;
constexpr size_t WS_VT = 334 * MiB;
constexpr size_t WS_SHW = 368 * MiB;
constexpr size_t WS_END = 369 * MiB;
constexpr size_t WS_ROWSS = 576 * 1024;
constexpr size_t SUB = 34 * MiB;

struct Params {
    const float* in[25];
    float* out; unsigned char* ws;
    int ph_lo, ph_hi;
};
enum { I_X = 0, I_C, I_CTX, I_CCTX, I_MODW, I_MODB, I_MIXG, I_FFNG, I_CONV_IN, I_CONV_W, I_CONV_OUT, I_NAT_QKV, I_NAT_RPB, I_NAT_O,
       I_MLA_DQ, I_MLA_QG, I_MLA_UQ, I_MLA_DKV, I_MLA_KVG, I_MLA_UKV, I_MLA_O, I_FNET_O, I_FFN_IN, I_FFN_OUT, I_FINAL_G };

__device__ __forceinline__ unsigned f2bf(float f) { unsigned u = __float_as_uint(f); return (u + 0x7fffu + ((u >> 16) & 1u)) >> 16; }
__device__ __forceinline__ unsigned pk2(float lo, float hi) { return f2bf(lo) | (f2bf(hi) << 16); }

struct TrItem { const float* src; bf16_t* dst; int N, K; };
__device__ __forceinline__ TrItem transpose_decode(const float* W, int K, int N, int kind, bf16_t* D0, bf16_t* D1, int item) {
    const int nblk = N / 32, kb = item / nblk, nb = item % nblk, k0 = 64 * kb, n0 = 32 * nb;
    bf16_t* D = D0; int drow = n0;
    if (kind == 1) { const int j = n0 < FH ? n0 : n0 - FH; drow = 256 * (j / 128) + (j % 128) + (n0 < FH ? 0 : 128); }
    else if (kind == 2) { if (n0 >= 1024) { const int j = (n0 - 1024) & 1023; drow = 1024 + 256 * (j / 128) + (j % 128) + (n0 >= 2048 ? 128 : 0); } }
    else if (kind == 3) { if (n0 >= 2048) { D = D1; drow = n0 - 2048; } }
    else if (kind == 6) { const int hh = n0 / 96, t = (n0 % 96) / 32; drow = t < 2 ? hh * 64 + 32 * t : 1024 + hh * 32; }
    else if (kind == 7) { const int hh = n0 / 128, j = n0 % 128; if (j < 64) drow = hh * 64 + j; else { D = D1; drow = hh * 64 + j - 64; } }
    TrItem t; t.src = W + (size_t)k0 * N + n0; t.dst = D + (size_t)drow * K + k0; t.N = N; t.K = K; return t;
}
__device__ __forceinline__ void transpose_load(const TrItem& t, float (&wv)[32], int lane) {
#pragma unroll
    for (int i = 0; i < 32; ++i) wv[i] = __builtin_nontemporal_load(t.src + (size_t)(2 * i + (lane >> 5)) * t.N + (lane & 31));
}
__device__ __forceinline__ void transpose_finish(const TrItem& t, const float (&wv)[32], LAS float* scr, int lane) {
#pragma unroll
    for (int i = 0; i < 32; ++i) scr[(2 * i + (lane >> 5)) * 33 + (lane & 31)] = wv[i];
    asm volatile("s_waitcnt lgkmcnt(0)" ::: "memory");
    const int c = lane & 7;
#pragma unroll
    for (int j = 0; j < 4; ++j) { const int n = (lane >> 3) + 8 * j; const LAS float* s = scr + (8 * c) * 33 + n;
        u32x4 o; o.x = pk2(s[0 * 33], s[1 * 33]); o.y = pk2(s[2 * 33], s[3 * 33]); o.z = pk2(s[4 * 33], s[5 * 33]); o.w = pk2(s[6 * 33], s[7 * 33]);
        *(u32x4*)(t.dst + (size_t)n * t.K + 8 * c) = o; }
    asm volatile("s_waitcnt lgkmcnt(0)" ::: "memory");
}

__device__ __forceinline__ void prep_phase(const Params& p, unsigned char* ws, LAS unsigned char* lds, int G, int bid, int tid, int wid, int lane) {
    {
        LAS float* sc = (LAS float*)lds;
        LAS float* red = (LAS float*)(lds + 20480);
        for (int idx = tid; idx < 5 * 1024; idx += 512) { const int r = idx >> 10, k = idx & 1023; const float v = r < 4 ? p.in[I_C][r * 1024 + k] : p.in[I_CCTX][k]; sc[idx] = silu_f(v); }
        __syncthreads();
        for (int item = bid; item < 256; item += G) {
        const int layer = item >> 6, chunk = item & 63;
        const bool act = lane < 48;
        const float* W = p.in[I_MODW] + (size_t)layer * 1024 * 6144 + chunk * 96 + 2 * (act ? lane : 0);
        float a[5][2];
#pragma unroll
        for (int r = 0; r < 5; ++r) { a[r][0] = 0.f; a[r][1] = 0.f; }
        const int kbeg = wid * 128;
        for (int k0 = kbeg; k0 < kbeg + 128; k0 += 32) {
            f32x2 w[32];
#pragma unroll
            for (int i = 0; i < 32; ++i) w[i] = __builtin_nontemporal_load((const f32x2*)(W + (size_t)(k0 + i) * 6144));
#pragma unroll
            for (int i = 0; i < 32; ++i)
#pragma unroll
                for (int r = 0; r < 5; ++r) { const float s = sc[r * 1024 + k0 + i]; a[r][0] += s * w[i].x; a[r][1] += s * w[i].y; }
        }
        if (act) {
#pragma unroll
            for (int r = 0; r < 5; ++r) { red[(wid * 5 + r) * 96 + 2 * lane] = a[r][0]; red[(wid * 5 + r) * 96 + 2 * lane + 1] = a[r][1]; }
        }
        __syncthreads();
        {
            for (int idx = tid; idx < 480; idx += 512) {
                const int r = idx / 96, cc = idx % 96; float s = 0.f;
#pragma unroll
                for (int w = 0; w < 8; ++w) s += red[(w * 5 + r) * 96 + cc];
                const int col = chunk * 96 + cc;
                ((float*)(ws + WS_MOD))[(layer * 5 + r) * 6144 + col] = s + p.in[I_MODB][layer * 6144 + col];
            }
        }
        __syncthreads();
        }
    }
    {
        LAS float* scr = (LAS float*)(lds + wid * 16384);
        const int gw = bid * 8 + wid, NGW = G * 8;
        constexpr int IT_CONV_IN = 16 * 96, IT_SQ = 16 * 32, IT_DQ = 16 * 8, IT_DKV = 16 * 9, IT_UQ = 4 * 48, IT_UKV = 4 * 64, IT_FIN = 16 * 176, IT_FOUT = 44 * 32;
        constexpr int NITEMS = IT_CONV_IN + IT_SQ + IT_CONV_IN + IT_SQ + IT_DQ + IT_DKV + IT_UQ + IT_UKV + IT_SQ + IT_SQ + 4 * IT_FIN + 4 * IT_FOUT;
#define DECODE_ITEM(it_, T_) do { const int it = (it_); \
            int r = it; const float* W; int K, N, kind = 0; bf16_t* D0; bf16_t* D1 = nullptr; \
            if (r < IT_CONV_IN) { W = p.in[I_CONV_IN]; K = 1024; N = 3072; kind = 2; D0 = (bf16_t*)(ws + WS_CONV_IN); } \
            else if ((r -= IT_CONV_IN) < IT_SQ) { W = p.in[I_CONV_OUT]; K = 1024; N = 1024; D0 = (bf16_t*)(ws + WS_CONV_OUT); } \
            else if ((r -= IT_SQ) < IT_CONV_IN) { W = p.in[I_NAT_QKV]; K = 1024; N = 3072; kind = 3; D0 = (bf16_t*)(ws + WS_NAT_QK); D1 = (bf16_t*)(ws + WS_NAT_V); } \
            else if ((r -= IT_CONV_IN) < IT_SQ) { W = p.in[I_NAT_O]; K = 1024; N = 1024; D0 = (bf16_t*)(ws + WS_NAT_O); } \
            else if ((r -= IT_SQ) < IT_DQ) { W = p.in[I_MLA_DQ]; K = 1024; N = 256; D0 = (bf16_t*)(ws + WS_MLA_A); } \
            else if ((r -= IT_DQ) < IT_DKV) { W = p.in[I_MLA_DKV]; K = 1024; N = 288; D0 = (bf16_t*)(ws + WS_MLA_A) + 256 * 1024; } \
            else if ((r -= IT_DKV) < IT_UQ) { W = p.in[I_MLA_UQ]; K = 256; N = 1536; kind = 6; D0 = (bf16_t*)(ws + WS_MLA_UQ); } \
            else if ((r -= IT_UQ) < IT_UKV) { W = p.in[I_MLA_UKV]; K = 256; N = 2048; kind = 7; D0 = (bf16_t*)(ws + WS_MLA_K); D1 = (bf16_t*)(ws + WS_MLA_V); } \
            else if ((r -= IT_UKV) < IT_SQ) { W = p.in[I_MLA_O]; K = 1024; N = 1024; D0 = (bf16_t*)(ws + WS_MLA_O); } \
            else if ((r -= IT_SQ) < IT_SQ) { W = p.in[I_FNET_O]; K = 1024; N = 1024; D0 = (bf16_t*)(ws + WS_FNET_O); } \
            else if ((r -= IT_SQ) < 4 * IT_FIN) { const int l = r / IT_FIN; r -= l * IT_FIN; W = p.in[I_FFN_IN] + (size_t)l * 1024 * 5632; K = 1024; N = 5632; kind = 1; D0 = (bf16_t*)(ws + WS_FFN_IN + l * FFN_IN_STRIDE); } \
            else { r -= 4 * IT_FIN; const int l = r / IT_FOUT; r -= l * IT_FOUT; W = p.in[I_FFN_OUT] + (size_t)l * FH * 1024; K = FH; N = 1024; D0 = (bf16_t*)(ws + WS_FFN_OUT + l * FFN_OUT_STRIDE); } \
            T_ = transpose_decode(W, K, N, kind, D0, D1, r); } while (0)
        float wvA[32], wvB[32]; TrItem tA, tB; tB = TrItem{nullptr, nullptr, 0, 0};
        if (gw < NITEMS) { DECODE_ITEM(gw, tA); transpose_load(tA, wvA, lane); }
        for (int it0 = gw; it0 < NITEMS; it0 += NGW) {
            const bool hasn = it0 + NGW < NITEMS;
            if (hasn) { DECODE_ITEM(it0 + NGW, tB); transpose_load(tB, wvB, lane); }
            transpose_finish(tA, wvA, scr, lane);
            if (hasn) { tA = tB;
#pragma unroll
                for (int i = 0; i < 32; ++i) wvA[i] = wvB[i]; }
        }
#undef DECODE_ITEM
    }
    const int gt = bid * 512 + tid, NGT = G * 512;
    { const f32x4* s4 = (const f32x4*)p.in[I_CTX]; f32x4* d4 = (f32x4*)(ws + WS_XC); for (int i = gt; i < MC * DM / 4; i += NGT) d4[i] = s4[i]; }
    { float* z = (float*)(ws + WS_ROWSS); for (int i = gt; i < 4 * ML; i += NGT) z[i] = 0.f; }
    { u32x4* z = (u32x4*)((bf16_t*)(ws + WS_MLA_A) + 544 * 1024); unsigned zu_ = 0u; asm volatile("" : "+v"(zu_)); for (int i = gt; i < 224 * 1024 / 8; i += NGT) z[i] = (u32x4){zu_, zu_, zu_, zu_}; }
    { bf16_t* A = (bf16_t*)(ws + WS_DFTA);
      for (int i = gt; i < 512 * 256; i += NGT) { const int f = i >> 8, c = i & 255, k2 = f & 255, ph = (c * k2) & 255; const float x = (float)ph * (1.f / 256.f);
          const float v = f < 256 ? __builtin_amdgcn_cosf(x) * 0.0625f : -__builtin_amdgcn_sinf(x) * 0.0625f; A[i] = (bf16_t)f2bf(v); } }
    { bf16_t* M1 = (bf16_t*)(ws + WS_DFTA) + 512 * 256; bf16_t* M2 = M1 + 256 * 256;
      for (int i = gt; i < 256 * 256; i += NGT) { const int rho = i >> 8, kap = i & 255; const int ro = rho >> 7, hh = (rho >> 6) & 1, ko = rho & 63, hf = kap >> 7, ri = (kap >> 6) & 1, ni = kap & 63;
          const float x = (float)((ni * ko) & 63) * (1.f / 64.f); const float c = __builtin_amdgcn_cosf(x) * 0.125f, s = __builtin_amdgcn_sinf(x) * 0.125f;
          const float v1 = hf != hh ? 0.f : (ro == 0 ? (ri == 0 ? c : s) : (ri == 0 ? -s : c));
          const float v2 = (hf != hh || ro != 0) ? 0.f : (ri == 0 ? c : s);
          M1[i] = (bf16_t)f2bf(v1); M2[i] = (bf16_t)f2bf(v2); } }
    { float* ct = (float*)(ws + WS_ROPE); float* st = ct + 4096 * 16;
      for (int i = gt; i < 4096 * 16; i += NGT) { const int pos = i >> 4, j = i & 15; const float fr = __builtin_amdgcn_exp2f(-(float)(j & 7) * 1.6609640474436812f);
          const float coord = (float)(j < 8 ? (pos >> 6) : (pos & 63)); const float rev = coord * fr * 0.15915494309189535f; ct[i] = __builtin_amdgcn_cosf(rev); st[i] = __builtin_amdgcn_sinf(rev); } }
}

__device__ __forceinline__ void norm_phase(const float* srcL, const float* srcC, int nrows, const float* g, const float* mod, int sh_off, int sc_off, bf16_t* H,
                                           const float* part, int npart, const float* pgate, float* XCw, int perm, int rbeg, int gw, int NGW, int lane) {
    for (int r0 = rbeg + gw; r0 < nrows; r0 += 2 * NGW) {
        const int r1 = r0 + NGW; const bool has1 = r1 < nrows;
        const float* xr0 = r0 < ML ? srcL + (size_t)r0 * DM : srcC + (size_t)(r0 - ML) * DM;
        const int r1c = has1 ? r1 : r0;
        const float* xr1 = r1c < ML ? srcL + (size_t)r1c * DM : srcC + (size_t)(r1c - ML) * DM;
        f32x4 v[2][4];
#pragma unroll
        for (int j = 0; j < 4; ++j) { v[0][j] = *(const f32x4*)(xr0 + (64 * j + lane) * 4); v[1][j] = *(const f32x4*)(xr1 + (64 * j + lane) * 4); }
#pragma unroll
        for (int q = 0; q < 2; ++q) {
            const int r = q ? r1c : r0;
            if (q == 1 && !has1) break;
            if (r >= ML && npart > 0) {
                f32x4 a4[4];
#pragma unroll
                for (int j = 0; j < 4; ++j) a4[j] = (f32x4){0.f, 0.f, 0.f, 0.f};
                for (int z = 0; z < npart; ++z) { const float* pr = part + ((size_t)(z * MC + (r - ML)) * DM);
#pragma unroll
                    for (int j = 0; j < 4; ++j) a4[j] += *(const f32x4*)(pr + (64 * j + lane) * 4); }
#pragma unroll
                for (int j = 0; j < 4; ++j) { v[q][j] += a4[j] * *(const f32x4*)(pgate + (64 * j + lane) * 4); *(f32x4*)(XCw + (size_t)(r - ML) * DM + (64 * j + lane) * 4) = v[q][j]; }
            }
            const float* mp = mod + mod_row(r) * 6144;
            const int nn_ = r & 4095, ro_ = perm ? (r & ~4095) + (nn_ & 31) * 128 + ((nn_ >> 5) & 1) * 64 + (nn_ >> 6) : r;
            float s = 0.f;
#pragma unroll
            for (int j = 0; j < 4; ++j) s += (v[q][j].x * v[q][j].x + v[q][j].y * v[q][j].y) + (v[q][j].z * v[q][j].z + v[q][j].w * v[q][j].w);
            const float rstd = rsqrtf(wave_sum(s) * (1.f / DM) + NORM_EPS);
#pragma unroll
            for (int j = 0; j < 4; ++j) { const int e = (64 * j + lane) * 4;
                const f32x4 gg = *(const f32x4*)(g + e), sc = *(const f32x4*)(mp + sc_off + e), sh = *(const f32x4*)(mp + sh_off + e);
                const f32x4 o = (v[q][j] * rstd) * gg * (sc + 1.0f) + sh;
                u32x2 w; w.x = cvt_pk_bf16(o[0], o[1]); w.y = cvt_pk_bf16(o[2], o[3]); *(u32x2*)(H + (size_t)ro_ * DM + e) = w; }
        }
    }
}
__device__ __forceinline__ void final_norm_phase(float* x, const float* g, int gw, int NGW, int lane) {
    constexpr int NR = 2;
    for (int r0 = gw; r0 < ML; r0 += NR * NGW) {
        f32x4 v[NR][4];
#pragma unroll
        for (int q = 0; q < NR; ++q) { const int rq = r0 + q * NGW; const float* xr = x + (size_t)(rq < ML ? rq : r0) * DM;
#pragma unroll
            for (int j = 0; j < 4; ++j) v[q][j] = *(const f32x4*)(xr + (64 * j + lane) * 4); }
#pragma unroll
        for (int q = 0; q < NR; ++q) {
            const int r = r0 + q * NGW; if (r >= ML) break;
            float* xr = x + (size_t)r * DM; float s = 0.f;
#pragma unroll
            for (int j = 0; j < 4; ++j) s += (v[q][j].x * v[q][j].x + v[q][j].y * v[q][j].y) + (v[q][j].z * v[q][j].z + v[q][j].w * v[q][j].w);
            const float rstd = rsqrtf(wave_sum(s) * (1.f / DM) + NORM_EPS);
#pragma unroll
            for (int j = 0; j < 4; ++j) { const int e = (64 * j + lane) * 4; *(f32x4*)(xr + e) = (v[q][j] * rstd) * *(const f32x4*)(g + e); }
        }
    }
}
#define UNPACK8(V_, f) do { f[0] = bf_lo(V_[0]); f[1] = bf_hi(V_[0]); f[2] = bf_lo(V_[1]); f[3] = bf_hi(V_[1]); f[4] = bf_lo(V_[2]); f[5] = bf_hi(V_[2]); f[6] = bf_lo(V_[3]); f[7] = bf_hi(V_[3]); } while (0)
__device__ __forceinline__ void conv_phase(const bf16_t* Bg, const bf16_t* U, const float* cw, bf16_t* ZG, int gw, int NGW, int lane) {
    for (int r0 = gw; r0 < MT; r0 += 2 * NGW) {
        u32x4 bgw[2][2], u0w[2][2], umw[2][2], upw[2][2];
        unsigned zu_ = 0u; asm volatile("" : "+v"(zu_)); const u32x4 zero = {zu_, zu_, zu_, zu_};
#pragma unroll
        for (int q = 0; q < 2; ++q) { const int rq = r0 + q * NGW; const int r = rq < MT ? rq : r0;
            int s, last; if (r < ML) { s = r & 4095; last = 4095; } else { s = (r - ML) & 255; last = 255; }
            const bool hasp = s > 0, hasn = s < last;
#pragma unroll
            for (int half = 0; half < 2; ++half) { const size_t o = (size_t)r * DM + (half * 64 + lane) * 8;
                bgw[q][half] = *(const u32x4*)(Bg + o); u0w[q][half] = *(const u32x4*)(U + o);
                umw[q][half] = hasp ? *(const u32x4*)(U + o - DM) : zero; upw[q][half] = hasn ? *(const u32x4*)(U + o + DM) : zero; } }
#pragma unroll
        for (int q = 0; q < 2; ++q) { const int r = r0 + q * NGW; if (r >= MT) break;
#pragma unroll
            for (int half = 0; half < 2; ++half) {
                const int e = (half * 64 + lane) * 8; const size_t o = (size_t)r * DM + e;
                float bg[8], u0[8], um[8], up[8], z[8]; UNPACK8(bgw[q][half], bg); UNPACK8(u0w[q][half], u0); UNPACK8(umw[q][half], um); UNPACK8(upw[q][half], up);
#pragma unroll
                for (int k4 = 0; k4 < 2; ++k4) { const f32x4 w0 = *(const f32x4*)(cw + e + 4 * k4), w1 = *(const f32x4*)(cw + DM + e + 4 * k4), w2 = *(const f32x4*)(cw + 2 * DM + e + 4 * k4);
#pragma unroll
                    for (int k = 0; k < 4; ++k) z[4 * k4 + k] = bg[4 * k4 + k] * (w0[k] * um[4 * k4 + k] + w1[k] * u0[4 * k4 + k] + w2[k] * up[4 * k4 + k]); }
                u32x4 w; w.x = cvt_pk_bf16(z[0], z[1]); w.y = cvt_pk_bf16(z[2], z[3]); w.z = cvt_pk_bf16(z[4], z[5]); w.w = cvt_pk_bf16(z[6], z[7]);
                *(u32x4*)(ZG + o) = w;
            }
        }
    }
}
__device__ __forceinline__ void mla_thin_phase(const bf16_t* CQ, const float* qg, const float* kvg, const float* cosT, const float* sinT, bf16_t* cqn, bf16_t* ckvn, bf16_t* Kr, int gw, int NGW, int lane) {
    for (int r = gw; r < MT; r += NGW) {
        const bf16_t* row = CQ + (size_t)r * 768;
        const u32x2 a = *(const u32x2*)(row + 4 * lane), b = *(const u32x2*)(row + 256 + 4 * lane);
        const float a0 = bf_lo(a.x), a1 = bf_hi(a.x), a2 = bf_lo(a.y), a3 = bf_hi(a.y), b0 = bf_lo(b.x), b1 = bf_hi(b.x), b2 = bf_lo(b.y), b3 = bf_hi(b.y);
        const float ra = rsqrtf(wave_sum(a0 * a0 + a1 * a1 + a2 * a2 + a3 * a3) * (1.f / 256.f) + NORM_EPS);
        const float rb = rsqrtf(wave_sum(b0 * b0 + b1 * b1 + b2 * b2 + b3 * b3) * (1.f / 256.f) + NORM_EPS);
        const f32x4 g1 = *(const f32x4*)(qg + 4 * lane), g2 = *(const f32x4*)(kvg + 4 * lane);
        u32x2 w; w.x = cvt_pk_bf16(a0 * ra * g1[0], a1 * ra * g1[1]); w.y = cvt_pk_bf16(a2 * ra * g1[2], a3 * ra * g1[3]); *(u32x2*)(cqn + (size_t)r * 256 + 4 * lane) = w;
        w.x = cvt_pk_bf16(b0 * rb * g2[0], b1 * rb * g2[1]); w.y = cvt_pk_bf16(b2 * rb * g2[2], b3 * rb * g2[3]); *(u32x2*)(ckvn + (size_t)r * 256 + 4 * lane) = w;
        if (lane < 16) {
            const float x1 = __uint_as_float((unsigned)row[512 + lane] << 16), x2 = __uint_as_float((unsigned)row[528 + lane] << 16);
            float o1 = x1, o2 = x2;
            if (r < ML) { const int pos = r & 4095; const float cs = cosT[pos * 16 + lane], sn = sinT[pos * 16 + lane]; o1 = x1 * cs - x2 * sn; o2 = x1 * sn + x2 * cs; }
            Kr[(size_t)r * 32 + lane] = (bf16_t)f2bf(o1); Kr[(size_t)r * 32 + 16 + lane] = (bf16_t)f2bf(o2);
        }
    }
}

__device__ __forceinline__ void shw_phase(const float* MOD, const unsigned char* ws, float* SHW, int gw, int NGW, int lane) {
    for (int it = gw; it < 4 * 2 * FH; it += NGW) {
        const int L = it / (2 * FH), n = it % (2 * FH);
        const bf16_t* wrow = (const bf16_t*)(ws + WS_FFN_IN + L * FFN_IN_STRIDE) + (size_t)n * DM;
        const u32x4 w0 = *(const u32x4*)(wrow + 8 * lane), w1 = *(const u32x4*)(wrow + 512 + 8 * lane);
        float wf[16]; UNPACK8(w0, wf); { float* wf8 = wf + 8; UNPACK8(w1, wf8); }
#pragma unroll
        for (int mr = 0; mr < 5; ++mr) {
            const float* sh = MOD + (L * 5 + mr) * 6144 + 3072;
            float acc = 0.f;
#pragma unroll
            for (int q = 0; q < 2; ++q) { const f32x4 s0 = *(const f32x4*)(sh + 512 * q + 8 * lane), s1 = *(const f32x4*)(sh + 512 * q + 8 * lane + 4);
                acc += (s0[0] * wf[8 * q] + s0[1] * wf[8 * q + 1]) + (s0[2] * wf[8 * q + 2] + s0[3] * wf[8 * q + 3]) + (s1[0] * wf[8 * q + 4] + s1[1] * wf[8 * q + 5]) + (s1[2] * wf[8 * q + 6] + s1[3] * wf[8 * q + 7]); }
            acc = wave_sum(acc);
            if (lane == 0) SHW[(size_t)(L * 6 + mr) * (2 * FH) + n] = acc;
        }
        if (lane == 0) SHW[(size_t)(L * 6 + 5) * (2 * FH) + n] = 0.f;
    }
}

template <int MODE>
__device__ __forceinline__ void attn_tile(const LAS unsigned char* bufp, LAS unsigned char* lds, const bf16x8 (&qf)[MODE == 0 ? 6 : 4], f32x16 (&o)[2], f32x16& negm, float& m_ref, float& lsum, bool& started,
                                          bool band, int rr, int qrow, int qc, int c0, int prow, int l32, int hi) {
    constexpr int DQ = MODE == 0 ? 96 : 64, NKS = DQ / 16, KP = DQ * 2 + 16, VP = 144, KBYTES = 64 * KP;
    constexpr int BIAS_OFF = 98304;
            const LAS unsigned char* kp = bufp;
            const LAS unsigned char* vp = kp + KBYTES;
            f32x16 s[2];
            bf16x8 kf[NKS][2];
#pragma unroll
            for (int ks = 0; ks < NKS; ++ks)
#pragma unroll
                for (int kh = 0; kh < 2; ++kh) kf[ks][kh] = *(const LAS bf16x8*)(kp + (32 * kh + prow) * KP + (16 * ks + 8 * hi) * 2);
            __builtin_amdgcn_sched_barrier(0);
            __builtin_amdgcn_s_setprio(1);
#pragma unroll
            for (int ks = 0; ks < NKS; ++ks)
#pragma unroll
                for (int kh = 0; kh < 2; ++kh) s[kh] = __builtin_amdgcn_mfma_f32_32x32x16_bf16(kf[ks][kh], qf[ks], ks == 0 ? negm : s[kh], 0, 0, 0);
            __builtin_amdgcn_s_setprio(0);
            if (MODE == 1 && band) {
                const LAS float* bl = (const LAS float*)(lds + BIAS_OFF) + (rr - qrow + 7) * 128 + (63 - qc + 8 * hi);
#pragma unroll
                for (int kh = 0; kh < 2; ++kh)
#pragma unroll
                    for (int i = 0; i < 16; ++i) { const int kcl = 32 * kh + 16 * (i >> 3) + (i & 7); const int kc = kcl + 8 * hi;
                        const bool valid = (unsigned)(kc - c0) < 16u; s[kh][i] = valid ? s[kh][i] + bl[kcl] : -1.0e30f; }
            }
            float mx = fmaxf(s[0][0], s[1][0]);
#pragma unroll
            for (int i = 1; i < 16; ++i) mx = fmaxf(fmaxf(mx, s[0][i]), s[1][i]);
            mx = xor32_max(mx);
            const float delta = (!started || mx > 8.0f) ? mx : 0.f;
            if (__builtin_amdgcn_ballot_w64(delta != 0.f) != 0ull) {
                const float alpha = started ? __builtin_amdgcn_exp2f(-delta) : 1.0f;
                lsum *= alpha; m_ref += delta;
#pragma unroll
                for (int i = 0; i < 16; ++i) negm[i] = -m_ref;
#pragma unroll
                for (int i = 0; i < 16; ++i) { o[0][i] *= alpha; o[1][i] *= alpha; s[0][i] -= delta; s[1][i] -= delta; }
            }
            started = true;
            bf16x8 vf[2][2][2];
#pragma unroll
            for (int kh = 0; kh < 2; ++kh)
#pragma unroll
                for (int t = 0; t < 2; ++t)
#pragma unroll
                    for (int dh = 0; dh < 2; ++dh) vf[kh][t][dh] = *(const LAS bf16x8*)(vp + (32 * dh + l32) * VP + (32 * kh + 16 * t + 8 * hi) * 2);
            __builtin_amdgcn_sched_barrier(0);
            float ps = 0.f;
#pragma unroll
            for (int kh = 0; kh < 2; ++kh)
#pragma unroll
                for (int i = 0; i < 16; ++i) { const float pv = __builtin_amdgcn_exp2f(s[kh][i]); s[kh][i] = pv; ps += pv; }
            lsum += ps;
            bf16x8 pf[2][2];
#pragma unroll
            for (int kh = 0; kh < 2; ++kh)
#pragma unroll
                for (int t = 0; t < 2; ++t) { u32x4 w; w.x = cvt_pk_bf16(s[kh][8 * t + 0], s[kh][8 * t + 1]); w.y = cvt_pk_bf16(s[kh][8 * t + 2], s[kh][8 * t + 3]);
                    w.z = cvt_pk_bf16(s[kh][8 * t + 4], s[kh][8 * t + 5]); w.w = cvt_pk_bf16(s[kh][8 * t + 6], s[kh][8 * t + 7]); pf[kh][t] = __builtin_bit_cast(bf16x8, w); }
#pragma unroll
            for (int kh = 0; kh < 2; ++kh)
#pragma unroll
                for (int t = 0; t < 2; ++t)
#pragma unroll
                    for (int dh = 0; dh < 2; ++dh) { __builtin_amdgcn_s_setprio(1); o[dh] = __builtin_amdgcn_mfma_f32_32x32x16_bf16(vf[kh][t][dh], pf[kh][t], o[dh], 0, 0, 0); __builtin_amdgcn_s_setprio(0); }
}
template <int MODE>
__device__ __forceinline__ void attn_unit(LAS unsigned char* lds, int b, int h, int uq, const bf16_t* Qn, const bf16_t* Qr, const bf16_t* Kn, const bf16_t* Kr, const bf16_t* Vt,
                                          bf16_t* O, const float* rpb_h, const float* cosT, const float* sinT, float qscale, int tid, int wid, int lane) {
    constexpr int DQ = MODE == 0 ? 96 : 64, NKS = DQ / 16, KP = DQ * 2 + 16, VP = 144, KBYTES = 64 * KP, BUFB = KBYTES + 64 * VP;
    constexpr int BIAS_OFF = 98304;
    const int l32 = lane & 31, hi = lane >> 5;
    int q0, T, nb = 0, R0 = 0, qrow = 0, r0w = 0, qc = 0, c0 = 0;
    if (MODE == 0) { q0 = b * SEQ + uq * 256 + wid * 32; T = NKEY / 64; }
    else if (MODE == 1) { qrow = 4 * uq + (wid >> 1); q0 = b * SEQ + qrow * 64 + 32 * (wid & 1);
        R0 = min(max(4 * uq - 4, 0), 56); const int lastr = min(max(4 * uq - 1, 0), 56) + 7; nb = lastr - R0 + 1; T = nb + 4;
        r0w = min(max(qrow - 4, 0), 56); qc = 32 * (wid & 1) + l32; c0 = min(max(qc - 8, 0), 48); }
    else { q0 = ML + b * CTXL + wid * 32; T = 4; }
    bf16x8 qf[NKS];
#pragma unroll
    for (int ks = 0; ks < 4; ++ks) qf[ks] = *(const bf16x8*)(Qn + (size_t)(q0 + l32) * 1024 + h * 64 + 16 * ks + 8 * hi);
    if (MODE == 0) {
        const u32x4 r1 = *(const u32x4*)(Qr + (size_t)(q0 + l32) * 512 + h * 32 + 8 * hi), r2 = *(const u32x4*)(Qr + (size_t)(q0 + l32) * 512 + h * 32 + 16 + 8 * hi);
        const int pos = (q0 + l32) & 4095;
        const f32x4 ca = *(const f32x4*)(cosT + pos * 16 + 8 * hi), cb = *(const f32x4*)(cosT + pos * 16 + 8 * hi + 4);
        const f32x4 sa = *(const f32x4*)(sinT + pos * 16 + 8 * hi), sb = *(const f32x4*)(sinT + pos * 16 + 8 * hi + 4);
        u32x4 w1, w2;
#pragma unroll
        for (int i = 0; i < 4; ++i) {
            const float x1l = bf_lo(r1[i]), x1h = bf_hi(r1[i]), x2l = bf_lo(r2[i]), x2h = bf_hi(r2[i]);
            const float cl = i < 2 ? ca[2 * i] : cb[2 * i - 4], ch = i < 2 ? ca[2 * i + 1] : cb[2 * i - 3];
            const float sl = i < 2 ? sa[2 * i] : sb[2 * i - 4], sh = i < 2 ? sa[2 * i + 1] : sb[2 * i - 3];
            w1[i] = cvt_pk_bf16((x1l * cl - x2l * sl) * qscale, (x1h * ch - x2h * sh) * qscale);
            w2[i] = cvt_pk_bf16((x1l * sl + x2l * cl) * qscale, (x1h * sh + x2h * ch) * qscale);
        }
        qf[4] = __builtin_bit_cast(bf16x8, w1); qf[5] = __builtin_bit_cast(bf16x8, w2);
    }
    if (MODE == 1) { LAS float* bl = (LAS float*)(lds + BIAS_OFF);
        for (int idx = tid; idx < 15 * 128; idx += 512) { const int ro = idx >> 7, cc = idx & 127; bl[idx] = (cc >= 48 && cc < 79) ? rpb_h[ro * 31 + cc - 48] * LOG2E : 0.f; } }
    const int skey = tid >> 3, sch = tid & 7;
    const bf16_t* vbase = Vt + (size_t)(b * DM + h * 64 + skey) * NKEY + sch * 8;
    u32x4 kreg0, rreg0, vreg0, kreg1, rreg1, vreg1;
    rreg0.x = 0u; asm volatile("" : "+v"(rreg0.x)); rreg0.y = rreg0.x; rreg0.z = rreg0.x; rreg0.w = rreg0.x; rreg1 = rreg0;
#define TILE_KB(j) (MODE == 0 ? 64 * (j) : (MODE == 1 ? ((j) < nb ? (R0 + (j)) * 64 : SEQ + ((j) - nb) * 64) : SEQ + 64 * (j)))
#define GLD16(dst, ptr) asm volatile("global_load_dwordx4 %0, %1, off" : "=&v"(dst) : "v"(ptr) : "memory")
#define WAIT_VM0() asm volatile("s_waitcnt vmcnt(0)" ::: "memory")
#define GLOAD(j, S) do { if ((j) < T) { const int kb_ = TILE_KB(j), tk_ = key_tok(b, kb_); \
        GLD16(kreg##S, Kn + (size_t)(tk_ + skey) * 1024 + h * 64 + sch * 8); \
        if (MODE == 0) GLD16(rreg##S, Kr + (size_t)(tk_ + ((tid & 255) >> 2)) * 32 + (tid & 3) * 8); \
        GLD16(vreg##S, vbase + kb_); } } while (0)
#define LSTORE(j, S) do { if ((j) < T) { LAS unsigned char* bp_ = lds + ((((j) >> 1) & 1) * 2 + ((j) & 1)) * BUFB; \
        *(LAS u32x4*)(bp_ + skey * KP + sch * 16) = kreg##S; \
        if (MODE == 0) { if (tid < 256) *(LAS u32x4*)(bp_ + (tid >> 2) * KP + 128 + (tid & 3) * 16) = rreg##S; } \
        *(LAS u32x4*)(bp_ + KBYTES + skey * VP + sch * 16) = vreg##S; } } while (0)
#define BAR_LDS() do { asm volatile("s_waitcnt lgkmcnt(0)" ::: "memory"); __builtin_amdgcn_s_barrier(); asm volatile("" ::: "memory"); } while (0)
    GLOAD(0, 0); GLOAD(1, 1); WAIT_VM0(); LSTORE(0, 0); LSTORE(1, 1); GLOAD(2, 0); GLOAD(3, 1);
    BAR_LDS();
    f32x16 o[2];
#pragma unroll
    for (int i = 0; i < 16; ++i) { o[0][i] = 0.f; o[1][i] = 0.f; }
    float m_ref = 0.f, lsum = 0.f; bool started = false;
    f32x16 negm;
#pragma unroll
    for (int i = 0; i < 16; ++i) negm[i] = 0.f;
    const int prow = (l32 & ~12) | ((l32 & 4) << 1) | ((l32 & 8) >> 1);
#define ATT_TILE(j) do { if ((j) < T) { \
        bool band_ = false, active_ = true; int rr_ = 0; \
        if (MODE == 1 && (j) < nb) { band_ = true; rr_ = R0 + (j); active_ = (rr_ >= r0w) && (rr_ < r0w + 8); } \
        if (active_) attn_tile<MODE>(lds + ((((j) >> 1) & 1) * 2 + ((j) & 1)) * BUFB, lds, qf, o, negm, m_ref, lsum, started, band_, rr_, qrow, qc, c0, prow, l32, hi); } } while (0)
    for (int j = 0; j < T; j += 2) {
        ATT_TILE(j); ATT_TILE(j + 1);
        WAIT_VM0(); LSTORE(j + 2, 0); LSTORE(j + 3, 1);
        GLOAD(j + 4, 0); GLOAD(j + 5, 1);
        BAR_LDS();
    }
#undef ATT_TILE
#undef TILE_KB
#undef GLOAD
#undef LSTORE
#undef GLD16
#undef WAIT_VM0
#undef BAR_LDS
    const float ltot = xor32_sum(lsum), inv = 1.0f / ltot;
    bf16_t* obase = O + (size_t)(q0 + l32) * 1024 + h * 64 + (hi ? 8 : 0);
#pragma unroll
    for (int dh = 0; dh < 2; ++dh)
#pragma unroll
        for (int kp = 0; kp < 4; kp += 2) {
            unsigned ax = cvt_pk_bf16(o[dh][4 * kp] * inv, o[dh][4 * kp + 1] * inv), ay = cvt_pk_bf16(o[dh][4 * kp + 2] * inv, o[dh][4 * kp + 3] * inv);
            unsigned bx = cvt_pk_bf16(o[dh][4 * kp + 4] * inv, o[dh][4 * kp + 5] * inv), by = cvt_pk_bf16(o[dh][4 * kp + 6] * inv, o[dh][4 * kp + 7] * inv);
            const auto rx = __builtin_amdgcn_permlane32_swap(ax, bx, false, false); const auto ry = __builtin_amdgcn_permlane32_swap(ay, by, false, false);
            u32x4 w; w.x = rx[0]; w.y = ry[0]; w.z = rx[1]; w.w = ry[1];
            *(u32x4*)(obase + 32 * dh + 8 * kp) = w; }
}

#define XB_TMO      128
#define XB_XCNT(j)  (256  + 64 * (j))
#define XB_XSUB(j)  (1280 + 64 * (j))
#define XB_XGEN(j)  (2304 + 64 * (j))
#define XB_TOP      3328
#define XB_TOPGEN   3392
#define XCD_BAR_WORDS 3456
#define XB_SPIN_CAP (1u << 18)

__device__ __forceinline__ unsigned xb_ld(unsigned* p)              { return __hip_atomic_load(p, __ATOMIC_RELAXED, __HIP_MEMORY_SCOPE_AGENT); }
__device__ __forceinline__ unsigned xb_add(unsigned* p, unsigned v) { return __hip_atomic_fetch_add(p, v, __ATOMIC_RELAXED, __HIP_MEMORY_SCOPE_AGENT); }
__device__ __forceinline__ unsigned xb_xcc_id() { return (unsigned)__builtin_amdgcn_s_getreg((3 << 11) | 20) & 0xFu; }
#define XB_SPIN(cond, bar) do { unsigned _sp = 0; while (cond) { __builtin_amdgcn_s_sleep(1); \
    if ((++_sp & 255u) == 0u) { if (xb_ld(&(bar)[XB_TMO])) break; if (_sp > XB_SPIN_CAP) { atomicAdd(&(bar)[XB_TMO], 1u); break; } } } } while (0)

struct XcdBarrier {
    unsigned* bar; unsigned x;
    volatile LAS unsigned* st;
};

__device__ __forceinline__ XcdBarrier xcd_barrier_post(unsigned* bar, volatile LAS unsigned* st) {
    XcdBarrier b; b.bar = bar; b.x = xb_xcc_id(); b.st = st;
    if (threadIdx.x == 0) (void)xb_add(&bar[XB_XCNT(b.x)], 1u);
    return b;
}
__device__ __forceinline__ void xcd_barrier_complete(unsigned* bar, unsigned x, unsigned& nloc, unsigned& nx) {
    const unsigned G = gridDim.x * gridDim.y * gridDim.z;
    unsigned sum, cnt, mine, sp = 0u;
    for (;;) {
        sum = 0u; cnt = 0u; mine = 0u;
#pragma unroll
        for (unsigned j = 0; j < 16; ++j) { const unsigned c = xb_ld(&bar[XB_XCNT(j)]); sum += c; cnt += (c > 0u) ? 1u : 0u; mine = (j == x) ? c : mine; }
        if (sum == G) break;
        __builtin_amdgcn_s_sleep(1);
        if ((++sp & 255u) == 0u) { if (xb_ld(&bar[XB_TMO])) break; if (sp > XB_SPIN_CAP) { atomicAdd(&bar[XB_TMO], 1u); break; } }
    }
    nloc = mine > 0u ? mine : 1u; nx = cnt > 0u ? cnt : 1u;
}

__device__ __forceinline__ void xcd_barrier(const XcdBarrier& b) {
    asm volatile("s_waitcnt vmcnt(0)" ::: "memory");
    __syncthreads();
    if (threadIdx.x == 0) {
        unsigned* bar = b.bar;
        __builtin_amdgcn_s_waitcnt(0);
        unsigned nloc = b.st[0], nx = b.st[1];
        if (nloc == 0u) { xcd_barrier_complete(bar, b.x, nloc, nx); b.st[0] = nloc; b.st[1] = nx; }
        const unsigned old = xb_add(&bar[XB_XSUB(b.x)], 1u);
        const unsigned gen = old / nloc;
        if (old + 1u == (gen + 1u) * nloc) {
            __builtin_amdgcn_fence(__ATOMIC_RELEASE, "agent");
            asm volatile("s_waitcnt vmcnt(0)" ::: "memory");
            const unsigned og = xb_add(&bar[XB_TOP], 1u);
            const unsigned tg = og / nx;
            if (og + 1u == (tg + 1u) * nx) xb_add(&bar[XB_TOPGEN], 1u);
            else XB_SPIN(xb_ld(&bar[XB_TOPGEN]) == tg, bar);
            __builtin_amdgcn_fence(__ATOMIC_ACQUIRE, "agent");
            xb_add(&bar[XB_XGEN(b.x)], 1u);
            asm volatile("s_waitcnt vmcnt(0)" ::: "memory");
        } else {
            XB_SPIN(xb_ld(&bar[XB_XGEN(b.x)]) == gen, bar);
            __builtin_amdgcn_fence(__ATOMIC_ACQUIRE, "agent");
            asm volatile("s_waitcnt vmcnt(0)" ::: "memory");
        }
    }
    __syncthreads();
}

#ifndef FUSE_FFN_NORM
#define FUSE_FFN_NORM 0
#endif
constexpr int NPHASES = 38;
constexpr int LDS_BYTES = 147456, MISC_OFF = 131072 + 320;
constexpr size_t WS_CTL = 512 * 1024, CTL_BYTES = 16384;
__host__ __device__ __forceinline__ bool phase_empty(int ph) {
    if (ph == 0 || ph == NPHASES - 1) return false;
    const int L = (ph - 1) / 9, lp = (ph - 1) % 9;
    if (lp == 2) return !(L == 0 || L == 2);
    if (lp == 3) return !(L == 2 || L == 3);
    if (lp == 4) return L == 0;
    if (lp == 6) return FUSE_FFN_NORM && L >= 2;
    return false;
}

#ifndef PROBE_PH
#define PROBE_PH (-1)
#define PROBE_REPS 1
#endif
#ifndef PROBE_BAR_ONLY
#define PROBE_BAR_ONLY 0
#endif
template <bool COOP>
__global__ void __launch_bounds__(512, 2) fwd_kernel(Params p) {
    extern __shared__ __attribute__((aligned(16))) unsigned char lds_raw[];
    LAS unsigned char* lds = (LAS unsigned char*)lds_raw;
    const int tid0 = threadIdx.x;
    volatile LAS unsigned* MISC = (volatile LAS unsigned*)(lds + MISC_OFF);
    if (tid0 < 32) MISC[tid0] = 0u;
    __syncthreads();
    XcdBarrier bar; bar.bar = nullptr; bar.x = 0; bar.st = nullptr;
    if (COOP) bar = xcd_barrier_post((unsigned*)(p.ws + WS_CTL), MISC + 8);

    for (int ph = p.ph_lo; ph < p.ph_hi; ++ph) {
        if (phase_empty(ph)) continue;
        for (int rep = 0; rep < ((ph == PROBE_PH) ? PROBE_REPS : 1); ++rep) {
        if (rep > 0) { if (COOP) xcd_barrier(bar); if (PROBE_BAR_ONLY) continue; }
        int tid = tid0; asm volatile("" : "+v"(tid));
        size_t wsoff = 0; asm volatile("" : "+s"(wsoff)); unsigned char* ws = p.ws + wsoff;
        int G = gridDim.x, bid = blockIdx.x; asm volatile("" : "+s"(G), "+s"(bid));
        const int vcu = (G % 8 == 0) ? (bid % 8) * (G / 8) + bid / 8 : bid;
        const int lane = tid & 63, wid = __builtin_amdgcn_readfirstlane(tid >> 6);
        const int gw = bid * 8 + wid, NGW = G * 8;
        float* MOD = (float*)(ws + WS_MOD);
        const float* cosT = (const float*)(ws + WS_ROPE); const float* sinT = cosT + 4096 * 16;
        bf16_t* H = (bf16_t*)(ws + WS_H);
        bf16_t* BIG = (bf16_t*)(ws + WS_BIG);
        bf16_t* BIG1 = (bf16_t*)(ws + WS_BIG + SUB);
        bf16_t* BIG2 = (bf16_t*)(ws + WS_BIG + 2 * SUB);
        bf16_t* ZG = (bf16_t*)(ws + WS_ZG);
        bf16_t* CQN = ZG; bf16_t* CKVN = (bf16_t*)(ws + WS_ZG + 9 * MiB); bf16_t* QR = (bf16_t*)(ws + WS_ZG + 18 * MiB);
        bf16_t* VT = (bf16_t*)(ws + WS_VT);
        bf16_t* KR = (bf16_t*)(ws + WS_KR);
        float* XC = (float*)(ws + WS_XC);
        if (ph == 0) {
#ifndef NO_PREP
            prep_phase(p, ws, lds, G, bid, tid, wid, lane);
#endif
        }
        else if (ph == NPHASES - 1) final_norm_phase(p.out, p.in[I_FINAL_G], gw, NGW, lane);
        else {
            const int L = (ph - 1) / 9, lp = (ph - 1) % 9;
            const float* modL = MOD + L * 5 * 6144;
            const float* srcL = L == 0 ? p.in[I_X] : p.out; const float* srcC = L == 0 ? p.in[I_CTX] : XC;
            const int nMf = L < 2 ? MT / 256 : ML / 256;
            bf16_t* HN = (FUSE_FFN_NORM && (L == 1 || L == 2)) ? ZG : H;
            if (FUSE_FFN_NORM && lp == 0 && L == 0) shw_phase(MOD, ws, (float*)(ws + WS_SHW), gw, NGW, lane);
            if (lp == 0) norm_phase(srcL, srcC, L < 3 ? MT : ML, p.in[I_MIXG] + L * DM, modL, 0, 1024, H, (const float*)ZG, (L == 1 || L == 2) ? 11 : 0, modL - 5 * 6144 + 4 * 6144 + 5120, XC, L == 3, 0, gw, NGW, lane);
            else if (lp == 6) norm_phase(p.out, XC, L < 2 ? MT : ML, p.in[I_FFNG] + L * DM, modL, 3072, 4096, HN, (const float*)VT, L < 2 ? 4 : 0, modL + 4 * 6144 + 2048, XC, 0, FUSE_FFN_NORM ? ML : 0, gw, NGW, lane);
            else if (lp == 2) {
                if (L == 0) conv_phase(BIG, BIG1, p.in[I_CONV_W], ZG, gw, NGW, lane);
                else mla_thin_phase(BIG2, p.in[I_MLA_QG], p.in[I_MLA_KVG], cosT, sinT, CQN, CKVN, KR, gw, NGW, lane);
            } else if (lp == 4 && L != 3) {
#ifndef NO_ATT
                if (L == 1) {
                    for (int u = vcu; u < 1024 + 64; u += G) {
                        if (u < 1024) { const int bh = u >> 4; attn_unit<1>(lds, bh >> 4, bh & 15, u & 15, BIG, nullptr, BIG1, nullptr, VT, H, p.in[I_NAT_RPB] + (bh & 15) * 15 * 31, nullptr, nullptr, 1.f, tid, wid, lane); }
                        else { const int bh = u - 1024; attn_unit<2>(lds, bh >> 4, bh & 15, 0, BIG, nullptr, BIG1, nullptr, VT, H, nullptr, nullptr, nullptr, 1.f, tid, wid, lane); }
                    }
                } else {
                    for (int u = vcu; u < 1024; u += G) { const int bh = u >> 4; attn_unit<0>(lds, bh >> 4, bh & 15, u & 15, BIG, QR, BIG1, KR, VT, H, nullptr, cosT, sinT, 0.10206207261596575f * LOG2E, tid, wid, lane); }
                }
#endif
            } else if (lp == 5 || lp == 8) {
                for (int job = 0; job < (L < 2 ? 2 : 1); ++job) {
                    pg8::Gemm g; pg8::ResidEpi E; pg8::Order S;
                    E.dstL = p.out; E.dstC = XC; E.srcC = XC; E.rbase = job ? ML : 0; E.atomic = job; E.part = (float*)(lp == 5 ? VT : ZG);
                    E.fuse = FUSE_FFN_NORM && (lp == 5 && job == 0); E.Hn = HN; E.g2 = p.in[I_FFNG] + L * DM; E.sc2 = modL + 4096; E.rowss = (float*)(ws + WS_ROWSS) + L * ML;
                    if (lp == 5) {
                        g.A = ((L == 0 || L == 3) ? ZG : H) + (job ? (size_t)ML * 1024 : 0); g.lda = 1024; g.ldb = 1024; g.K = job ? 256 : 1024;
                        g.Bt = (const bf16_t*)(ws + (L == 0 ? WS_CONV_OUT : L == 1 ? WS_NAT_O : L == 2 ? WS_MLA_O : WS_FNET_O));
                        E.srcL = srcL; E.gate = modL + 2048;
                        if (job) S.init(4, 4, 4, G, bid); else S.init(ML / 256, 4, 1, G, bid);
                    } else {
                        g.A = BIG + (job ? (size_t)ML * FH : 0); g.lda = FH; g.ldb = FH; g.K = job ? 256 : FH; g.Bt = (const bf16_t*)(ws + WS_FFN_OUT + L * FFN_OUT_STRIDE);
                        E.srcL = p.out; E.gate = modL + 5120;
                        if (job) S.init(4, 4, 11, G, bid); else S.init(ML / 256, 4, 1, G, bid);
                    }
                    g.zsA = job ? 512 : 0; g.zsB = job ? 512 : 0;
#ifndef NO_RESID
                    pg8::gemm_phase<pg8::ResidEpi, pg8::Order, true, true>(lds, g, S, E, tid);
#endif
                }
            } else if (lp == 7 || (lp == 1 && L == 0)) {
                pg8::Gemm g; pg8::PairEpi E; pg8::Order S;
                g.A = (lp == 7) ? HN : H; g.lda = 1024; g.ldb = 1024; g.K = 1024; g.zsA = 0; g.zsB = 0;
                E.fuse = FUSE_FFN_NORM && (lp == 7); E.rowss = (const float*)(ws + WS_ROWSS) + L * ML; E.shw = (const float*)(ws + WS_SHW) + (size_t)L * 6 * (2 * FH);
                if (lp == 7) { g.Bt = (const bf16_t*)(ws + WS_FFN_IN + L * FFN_IN_STRIDE); E.act = 1; E.pn0 = 0; E.O0 = BIG; E.ld0 = FH; E.O1 = BIG; E.ld1 = FH; S.init(nMf, 22, 1, G, bid); }
                else { g.Bt = (const bf16_t*)(ws + WS_CONV_IN); E.act = 0; E.pn0 = 4; E.O0 = BIG; E.ld0 = 1024; E.O1 = BIG1; E.ld1 = 1024; S.init(MT / 256, 12, 1, G, bid); }
                #ifndef NO_PAIR
                pg8::gemm_phase<pg8::PairEpi, pg8::Order, true, true>(lds, g, S, E, tid);
#endif
            } else {
                const int njobs = (lp == 1) ? (L == 1 ? 3 : 1) : (L == 2 ? 4 : 1);
                for (int job = 0; job < njobs; ++job) {
                    pg8::Gemm g; pg8::StoreEpi E; pg8::Order S;
                    g.zsA = 0; g.zsB = 0; E.mode = 0; E.s0 = 1.f; E.O1 = nullptr; E.ld1 = 0; E.zrows = 0; E.split = 1 << 30; E.ld0 = 1024; E.coff = 0;
                    if (lp == 1 && L == 1) {
                        g.lda = 1024; g.ldb = 1024; g.K = 1024;
                        const bool cx = job == 2;
                        const bool vjob = job == 1 || (cx && bid >= 32);
                        const size_t ro = cx ? (size_t)ML * 1024 : 0;
                        if (!vjob) { g.A = H + ro; g.Bt = (const bf16_t*)(ws + WS_NAT_QK); E.O0 = BIG + ro; E.s0 = 0.125f * LOG2E; E.split = 1024; E.O1 = BIG1 + ro; E.ld1 = 1024;
                            if (cx) S.init(4, 8, 1, 32, bid); else S.init(ML / 256, 8, 1, G, bid); }
                        else { g.A = (const bf16_t*)(ws + WS_NAT_V); g.Bt = H + ro; E.mode = 1; E.O0 = VT; E.coff = cx ? ML : 0;
                            if (cx) S.init(bid < 48 ? 4 : 0, 4, 1, 16, bid - 32); else S.init(4, ML / 256, 1, G, bid); }
                    }
                    else if (lp == 1 && L == 2) { g.A = H; g.Bt = (const bf16_t*)(ws + WS_MLA_A); g.lda = 1024; g.ldb = 1024; g.K = 1024; E.O0 = BIG2; E.ld0 = 768; S.init(MT / 256, 3, 1, G, bid); }
                    else if (lp == 1) { g.A = (const bf16_t*)(ws + WS_DFTA); g.Bt = H; g.lda = 256; g.ldb = 1024; g.K = 256; g.zsB = 512; E.mode = 2; E.O0 = BIG; S.init(2, ML / 256, 4, G, bid); }
                    else if (L == 2 && (job == 0 || (job == 3 && bid < 144))) { const bool cx = job == 3; const size_t ro = cx ? (size_t)ML : 0;
                        g.A = CKVN + ro * 256; g.Bt = (const bf16_t*)(ws + WS_MLA_K); g.lda = 256; g.ldb = 256; g.K = 256; E.O0 = BIG1 + ro * 1024;
                        if (cx) S.init(bid >= 128 ? 4 : 0, 4, 1, 16, bid - 128); else S.init(ML / 256, 4, 1, G, bid); }
                    else if (L == 2 && job == 2) { g.A = CQN; g.Bt = (const bf16_t*)(ws + WS_MLA_UQ); g.lda = 256; g.ldb = 256; g.K = 256;
                        E.O0 = BIG; E.s0 = 0.10206207261596575f * LOG2E; E.split = 1024; E.O1 = QR; E.ld1 = 512; S.init(ML / 256, 6, 1, G, bid); }
                    else if (L == 2) { const bool cx = job == 3; const size_t ro = cx ? (size_t)ML : 0;
                        g.A = (const bf16_t*)(ws + WS_MLA_V); g.Bt = CKVN + ro * 256; g.lda = 256; g.ldb = 256; g.K = 256; E.mode = 1; E.O0 = VT; E.coff = cx ? ML : 0;
                        if (cx) S.init(bid < 160 ? 4 : 0, 4, 1, 16, bid - 144); else S.init(4, ML / 256, 1, G, bid); }
                    else if (lp == 3) { g.A = (const bf16_t*)(ws + WS_DFTA) + 512 * 256; g.Bt = BIG; g.lda = 256; g.ldb = 256; g.K = 256; E.mode = 3; E.O0 = (bf16_t*)(ws + WS_DFTB); S.init(1, 512, 1, G, bid); }
                    else { g.A = (const bf16_t*)(ws + WS_DFTA) + 768 * 256; g.Bt = (const bf16_t*)(ws + WS_DFTB); g.lda = 256; g.ldb = 256; g.K = 256; E.mode = 4; E.O0 = ZG; S.init(1, 512, 1, G, bid); }
                    #ifndef NO_STORE
                    pg8::gemm_phase<pg8::StoreEpi, pg8::Order, true, true>(lds, g, S, E, tid);
#endif
                }
            }
        }
        }
        if (COOP) { if (ph + 1 < p.ph_hi) { if (ph == 0) cg::this_grid().sync(); else xcd_barrier(bar); } }
    }
}

#ifndef MK_MULTI
#define MK_MULTI 0
#endif
extern "C" void kernel_launch(void* const* d_in, const int* in_sizes, int n_in, void* d_out, int out_size, void* d_ws, size_t ws_size, hipStream_t stream) {
    static int grid = 0;
    if (grid == 0) {
        if (n_in != 25 || out_size != ML * DM || ws_size < WS_END) { fprintf(stderr, "kernel_launch: unexpected problem: n_in %d out %d ws %zu (need %zu)\n", n_in, out_size, ws_size, (size_t)WS_END); grid = -1; return; }
        int dev = 0, cus = 0, per_cu = 0;
        (void)hipGetDevice(&dev); (void)hipDeviceGetAttribute(&cus, hipDeviceAttributeMultiprocessorCount, dev);
        (void)hipFuncSetAttribute((const void*)fwd_kernel<true>, hipFuncAttributeMaxDynamicSharedMemorySize, LDS_BYTES);
        (void)hipFuncSetAttribute((const void*)fwd_kernel<false>, hipFuncAttributeMaxDynamicSharedMemorySize, LDS_BYTES);
        (void)hipOccupancyMaxActiveBlocksPerMultiprocessor(&per_cu, (const void*)fwd_kernel<true>, 512, LDS_BYTES);
        if (per_cu < 1) { fprintf(stderr, "kernel_launch: occupancy query says %d blocks per CU\n", per_cu); per_cu = 1; }
        (void)hipGetLastError();
        grid = cus;
        if (grid <= 0) grid = 256;
    }
    if (grid < 0) return;
    Params p{};
    for (int i = 0; i < 25; ++i) p.in[i] = (const float*)d_in[i];
    p.out = (float*)d_out; p.ws = (unsigned char*)d_ws;
#if MK_MULTI
    for (int ph = 0; ph < NPHASES; ++ph) {
        if (phase_empty(ph)) continue;
        p.ph_lo = ph; p.ph_hi = ph + 1;
        hipLaunchKernelGGL(fwd_kernel<false>, dim3(grid), dim3(512), LDS_BYTES, stream, p);
    }
#else
    p.ph_lo = 0; p.ph_hi = NPHASES;
    (void)hipMemsetAsync((char*)d_ws + WS_CTL, 0, CTL_BYTES, stream);
    void* args[] = {&p};
    hipError_t e = hipLaunchCooperativeKernel((const void*)fwd_kernel<true>, dim3(grid), dim3(512), args, LDS_BYTES, stream);
    if (e != hipSuccess) fprintf(stderr, "cooperative launch failed: %s (grid %d)\n", hipGetErrorString(e), grid);
#endif
}
```
